# Optimizing an MI355X kernel written in HIP

```python
import math
import jax, jax.numpy as jnp
from jax import lax
import numpy as np

D_MODEL = 1024
BATCH = 16
SEQ = 2048
DEPTH = 4

N_MIXERS = 4
HEAD_DIM = 64
N_HEADS = D_MODEL // HEAD_DIM
ROPE_THETA = 10000.0
EPS = 1e-6
NEG_INF = -1e30
GRID_W = 64
NA_ROWS_MAX = 8
NA_COLS = 16
DF_HEADS = N_HEADS // 2
DF_HALF = HEAD_DIM
Q_BLOCK = 128
CONV_WIDTH = 3
DIL_GROUPS = ((128, 1), (512, 4), (2048, 16))
N_EXPERTS = 16
EC_CAPACITY_FACTOR = 2
D_FF_EXPERT = 2 * D_MODEL

kernel_name = 'hybrid_bidir_encoder_block'


def _rms_norm(x, g):
    xf = x.astype(jnp.float32)
    y = xf * lax.rsqrt(jnp.mean(xf * xf, axis=-1, keepdims=True) + EPS)
    return (y * g.astype(jnp.float32)).astype(x.dtype)


def _rope(x, pos):
    half = x.shape[-1] // 2
    inv_freq = ROPE_THETA ** (-jnp.arange(half, dtype=jnp.float32) / half)
    ang = pos.astype(jnp.float32)[:, None] * inv_freq[None, :]
    cos, sin = jnp.cos(ang), jnp.sin(ang)
    xf = x.astype(jnp.float32)
    x1, x2 = xf[..., :half], xf[..., half:]
    return jnp.concatenate([x1 * cos - x2 * sin, x2 * cos + x1 * sin], axis=-1).astype(x.dtype)


def _neighborhood_attention(h, w_qkv, q_g, k_g, rpb, w_out):
    B, S, D = h.shape
    rows = S // GRID_W
    kr = min(NA_ROWS_MAX, rows)
    qkv = (h @ w_qkv).reshape(B, rows, GRID_W, 3, N_HEADS, HEAD_DIM)
    q, k, v = [qkv[:, :, :, i].transpose(0, 3, 1, 2, 4) for i in range(3)]
    q = _rms_norm(q, q_g) * (HEAD_DIM ** -0.5)
    k = _rms_norm(k, k_g)
    col = jnp.arange(GRID_W)
    col_start = jnp.clip(col - NA_COLS // 2, 0, GRID_W - NA_COLS)
    col_idx = col_start[:, None] + jnp.arange(NA_COLS)[None, :]
    dc = col_idx - col[:, None] + NA_COLS - 1
    onehot = jax.nn.one_hot(col_idx, GRID_W, dtype=v.dtype)
    gather_idx = jnp.broadcast_to(col_idx[None, None, :, None, :], (B, N_HEADS, GRID_W, kr, NA_COLS))

    def row_block(r):
        r0 = jnp.clip(r - kr // 2, 0, rows - kr)
        q_r = lax.dynamic_index_in_dim(q, r, axis=2, keepdims=False)
        k_blk = lax.dynamic_slice_in_dim(k, r0, kr, axis=2)
        v_blk = lax.dynamic_slice_in_dim(v, r0, kr, axis=2)
        s = jnp.einsum('bhcd,bhiwd->bhciw', q_r, k_blk)
        s = jnp.take_along_axis(s, gather_idx, axis=-1)
        dr = r0 + jnp.arange(kr) - r + NA_ROWS_MAX - 1
        bias = rpb[:, dr[None, :, None], dc[:, None, :]]
        s = s.astype(jnp.float32) + bias.astype(jnp.float32)[None]
        p = jax.nn.softmax(s.reshape(B, N_HEADS, GRID_W, kr * NA_COLS), axis=-1)
        p = p.reshape(B, N_HEADS, GRID_W, kr, NA_COLS).astype(v.dtype)
        p_dense = jnp.einsum('bhcij,cjw->bhciw', p, onehot)
        return jnp.einsum('bhciw,bhiwd->bhcd', p_dense, v_blk)

    o = lax.map(row_block, jnp.arange(rows))
    o = o.transpose(1, 0, 3, 2, 4).reshape(B, S, D)
    return o @ w_out


def _diff_attention(h, w_qkv, q_g, k_g, lq1, lk1, lq2, lk2, sub_g, w_out, lambda_init):
    B, S, D = h.shape
    pos = jnp.arange(S)
    qkv = (h @ w_qkv).reshape(B, S, 3, DF_HEADS, 2 * DF_HALF)
    q = qkv[:, :, 0].reshape(B, S, DF_HEADS, 2, DF_HALF).transpose(0, 2, 3, 1, 4)
    k = qkv[:, :, 1].reshape(B, S, DF_HEADS, 2, DF_HALF).transpose(0, 2, 3, 1, 4)
    v = qkv[:, :, 2].transpose(0, 2, 1, 3)
    q = _rope(_rms_norm(q, q_g), pos) * (DF_HALF ** -0.5)
    k = _rope(_rms_norm(k, k_g), pos)
    f32 = jnp.float32
    lam = (jnp.exp(jnp.sum(lq1.astype(f32) * lk1.astype(f32)))
           - jnp.exp(jnp.sum(lq2.astype(f32) * lk2.astype(f32))) + lambda_init)
    nb = S // Q_BLOCK
    qb = q.reshape(B, DF_HEADS, 2, nb, Q_BLOCK, DF_HALF).transpose(3, 0, 1, 2, 4, 5)

    def block(q_blk):
        s = jnp.einsum('bhcqd,bhckd->bhcqk', q_blk, k).astype(f32)
        p = jax.nn.softmax(s, axis=-1)
        a = p[:, :, 0] - lam * p[:, :, 1]
        return jnp.einsum('bhqk,bhkd->bhqd', a.astype(v.dtype), v)

    o = lax.map(block, qb)
    o = o.transpose(1, 2, 0, 3, 4).reshape(B, DF_HEADS, S, 2 * DF_HALF)
    o = _rms_norm(o, sub_g) * (1.0 - lambda_init)
    o = o.transpose(0, 2, 1, 3).reshape(B, S, D)
    return o @ w_out


def _short_conv(h, w_in, conv_w, w_out):
    B, S, D = h.shape
    b_gate, c_gate, u = jnp.split(h @ w_in, 3, axis=-1)
    z = c_gate * u
    z = lax.conv_general_dilated(
        z, conv_w[:, None, :].astype(z.dtype), window_strides=(1,),
        padding=[(CONV_WIDTH // 2, CONV_WIDTH // 2)],
        dimension_numbers=('NWC', 'WIO', 'NWC'), feature_group_count=D)
    return (b_gate * z) @ w_out


def _dilated_branch(q, k, v, radius, dil):
    B, H, S, hd = q.shape
    L = S // dil
    blk = radius
    nq = -(-L // blk)
    tail = nq * blk - L

    def sub(t):
        return t.reshape(B, H, L, dil, hd).transpose(0, 1, 3, 2, 4)

    qs = jnp.pad(sub(q), ((0, 0), (0, 0), (0, 0), (0, tail), (0, 0))).reshape(B, H, dil, nq, blk, hd)

    def windows(t):
        tp = jnp.pad(sub(t), ((0, 0), (0, 0), (0, 0), (blk, blk + tail), (0, 0)))
        tp = tp.reshape(B, H, dil, nq + 2, blk, hd)
        return jnp.concatenate([tp[:, :, :, j:j + nq] for j in range(3)], axis=4)

    kw, vw = windows(k), windows(v)
    s = jnp.einsum('bhrnqd,bhrnkd->bhrnqk', qs, kw).astype(jnp.float32)
    jq = jnp.arange(nq)[:, None] * blk + jnp.arange(blk)[None, :]
    jk = jnp.arange(nq)[:, None] * blk - blk + jnp.arange(3 * blk)[None, :]
    valid = ((jnp.abs(jk[:, None, :] - jq[:, :, None]) <= radius)
             & ((jk >= 0) & (jk < L))[:, None, :])
    s = jnp.where(valid, s, NEG_INF)
    lse = jax.nn.logsumexp(s, axis=-1)
    p = jnp.exp(s - lse[..., None]).astype(v.dtype)
    o = jnp.einsum('bhrnqk,bhrnkd->bhrnqd', p, vw)
    o = o.reshape(B, H, dil, nq * blk, hd)[:, :, :, :L].transpose(0, 1, 3, 2, 4).reshape(B, H, S, hd)
    lse = lse.reshape(B, H, dil, nq * blk)[..., :L].transpose(0, 1, 3, 2).reshape(B, H, S)
    return o, lse


def _dilated_attention(h, w_qkv, q_g, k_g, w_out):
    B, S, D = h.shape
    pos = jnp.arange(S)
    n_groups = len(DIL_GROUPS)
    qkv = (h @ w_qkv).reshape(B, S, n_groups, 3, N_HEADS, HEAD_DIM)
    outs, lses = [], []
    for g, (window, dil) in enumerate(DIL_GROUPS):
        q = qkv[:, :, g, 0].transpose(0, 2, 1, 3)
        k = qkv[:, :, g, 1].transpose(0, 2, 1, 3)
        v = qkv[:, :, g, 2].transpose(0, 2, 1, 3)
        q = _rope(_rms_norm(q, q_g), pos) * (HEAD_DIM ** -0.5)
        k = _rope(_rms_norm(k, k_g), pos)
        o, lse = _dilated_branch(q, k, v, window // (2 * dil), dil)
        outs.append(o)
        lses.append(lse)
    alpha = jax.nn.softmax(jnp.stack(lses, axis=0), axis=0)
    o = jnp.sum(alpha[..., None] * jnp.stack(outs, axis=0).astype(jnp.float32), axis=0).astype(h.dtype)
    o = o.transpose(0, 2, 1, 3).reshape(B, S, D)
    return o @ w_out


def _expert_choice_ffn(h, w_router, w_gate, w_up, w_down):
    B, S, D = h.shape
    cap = EC_CAPACITY_FACTOR * S // N_EXPERTS
    logits = jnp.einsum('bsd,de->bse', h, w_router).astype(jnp.float32)
    aff = jax.nn.softmax(logits, axis=-1)
    gate, idx = lax.top_k(aff.transpose(0, 2, 1), cap)
    b_idx = jnp.arange(B)[:, None, None]
    xin = h[b_idx, idx]
    a = jnp.einsum('becd,edf->becf', xin, w_gate)
    u = jnp.einsum('becd,edf->becf', xin, w_up)
    y = jnp.einsum('becf,efd->becd', jax.nn.silu(a) * u, w_down)
    y = y * gate[..., None].astype(y.dtype)
    return jnp.zeros_like(h).at[b_idx, idx].add(y)


def setup_inputs(seed: int = 0) -> dict:
    key = jax.random.key(seed)
    ks = iter(jax.random.split(key, 40))
    n_occ = [len(range(m, DEPTH, N_MIXERS)) for m in range(N_MIXERS)]
    nA, nB, nC, nD = n_occ
    D = D_MODEL
    f32 = jnp.float32

    def nrm(shape, scale):
        return jax.random.normal(next(ks), shape, f32) * scale

    def gain(shape):
        return 1.0 + 0.1 * jax.random.normal(next(ks), shape, f32)

    return {
        'x': nrm((BATCH, SEQ, D), 1.0),
        'norm_mix_g': gain((DEPTH, D)),
        'norm_ffn_g': gain((DEPTH, D)),
        'na_w_qkv': nrm((nA, D, 3 * D), D ** -0.5),
        'na_q_norm': gain((nA, HEAD_DIM)),
        'na_k_norm': gain((nA, HEAD_DIM)),
        'na_rpb': nrm((nA, N_HEADS, 2 * NA_ROWS_MAX - 1, 2 * NA_COLS - 1), 0.1),
        'na_w_out': nrm((nA, D, D), D ** -0.5),
        'df_w_qkv': nrm((nB, D, 3 * DF_HEADS * 2 * DF_HALF), D ** -0.5),
        'df_q_norm': gain((nB, DF_HALF)),
        'df_k_norm': gain((nB, DF_HALF)),
        'df_lambda_q1': nrm((nB, DF_HALF), 0.1),
        'df_lambda_k1': nrm((nB, DF_HALF), 0.1),
        'df_lambda_q2': nrm((nB, DF_HALF), 0.1),
        'df_lambda_k2': nrm((nB, DF_HALF), 0.1),
        'df_sub_norm': gain((nB, 2 * DF_HALF)),
        'df_w_out': nrm((nB, DF_HEADS * 2 * DF_HALF, D), D ** -0.5),
        'sc_w_in': nrm((nC, D, 3 * D), D ** -0.5),
        'sc_conv': nrm((nC, CONV_WIDTH, D), CONV_WIDTH ** -0.5),
        'sc_w_out': nrm((nC, D, D), D ** -0.5),
        'dl_w_qkv': nrm((nD, D, len(DIL_GROUPS) * 3 * N_HEADS * HEAD_DIM), D ** -0.5),
        'dl_q_norm': gain((nD, HEAD_DIM)),
        'dl_k_norm': gain((nD, HEAD_DIM)),
        'dl_w_out': nrm((nD, N_HEADS * HEAD_DIM, D), D ** -0.5),
        'moe_w_router': nrm((DEPTH, D, N_EXPERTS), D ** -0.5),
        'moe_w_gate': nrm((DEPTH, N_EXPERTS, D, D_FF_EXPERT), D ** -0.5),
        'moe_w_up': nrm((DEPTH, N_EXPERTS, D, D_FF_EXPERT), D ** -0.5),
        'moe_w_down': nrm((DEPTH, N_EXPERTS, D_FF_EXPERT, D), D_FF_EXPERT ** -0.5),
    }


def reference(x, norm_mix_g, norm_ffn_g,
              na_w_qkv, na_q_norm, na_k_norm, na_rpb, na_w_out,
              df_w_qkv, df_q_norm, df_k_norm, df_lambda_q1, df_lambda_k1,
              df_lambda_q2, df_lambda_k2, df_sub_norm, df_w_out,
              sc_w_in, sc_conv, sc_w_out,
              dl_w_qkv, dl_q_norm, dl_k_norm, dl_w_out,
              moe_w_router, moe_w_gate, moe_w_up, moe_w_down):
    for i in range(DEPTH):
        m, j = i % N_MIXERS, i // N_MIXERS
        hn = _rms_norm(x, norm_mix_g[i])
        if m == 0:
            mix = _neighborhood_attention(hn, na_w_qkv[j], na_q_norm[j], na_k_norm[j], na_rpb[j], na_w_out[j])
        elif m == 1:
            lambda_init = 0.8 - 0.6 * math.exp(-0.3 * i)
            mix = _diff_attention(hn, df_w_qkv[j], df_q_norm[j], df_k_norm[j],
                                  df_lambda_q1[j], df_lambda_k1[j], df_lambda_q2[j], df_lambda_k2[j],
                                  df_sub_norm[j], df_w_out[j], lambda_init)
        elif m == 2:
            mix = _short_conv(hn, sc_w_in[j], sc_conv[j], sc_w_out[j])
        else:
            mix = _dilated_attention(hn, dl_w_qkv[j], dl_q_norm[j], dl_k_norm[j], dl_w_out[j])
        x = x + mix
        x = x + _expert_choice_ffn(_rms_norm(x, norm_ffn_g[i]), moe_w_router[i],
                                   moe_w_gate[i], moe_w_up[i], moe_w_down[i])
    return x
```

```cpp
#include <hip/hip_runtime.h>
#include <cstdio>
#include <cstdint>
namespace pg8 {
#define PG8_LAS __attribute__((address_space(3)))
typedef unsigned short bf16_t;
typedef short bf16x8 __attribute__((ext_vector_type(8)));
typedef float f32x4 __attribute__((ext_vector_type(4)));
typedef unsigned u32x4 __attribute__((ext_vector_type(4)));
constexpr int BM = 256, BK = 64, HALF = 128, HTB = HALF * BK * 2  , STAGE_BYTES = 8 * HTB, NXCD = 8, WGM = 8;

__host__ __device__ __forceinline__ int lds_byte(int r, int c) { const int st = (r >> 4) * 2 + (c >> 5), rr = r & 15, cc = c & 31, ob = rr * 64 + cc * 2; return st * 1024 + (ob ^ (((ob >> 9) & 1) << 5)); }
__host__ __device__ __forceinline__ void stage_rc(int b, int& R, int& C) { const int st = b / 1024, sb = b % 1024, swz = sb ^ (((sb >> 9) & 1) << 5); R = (st >> 1) * 16 + swz / 64; C = (st & 1) * 32 + (swz % 64) / 2; }
__host__ __device__ __forceinline__ int perm32(int rho) { const int n = rho >> 4, i = rho & 15; return 8 * (i >> 2) + 4 * n + (i & 3); }

struct Unit { int pm, pn; };
struct Gemm { const bf16_t* A; const bf16_t* Bt; int M, N, K; };

struct StaticOrder {
    int nM, nN, nwg, G, c;
    __host__ __device__ void init(int M, int N, int G_, int c_) { nM = M / BM; nN = N / BM; nwg = nM * nN; G = G_; c = c_; }
    __host__ __device__ bool next(int i, Unit& u) const {
        const long L = (long)i * G + c; if (L >= nwg) return false;
        int wgid = (int)L; { const int q = nwg / NXCD, r = nwg % NXCD, xcd = wgid % NXCD, off = wgid / NXCD; wgid = (xcd < r ? xcd * (q + 1) : r * (q + 1) + (xcd - r) * q) + off; }
        const int nig = WGM * nN, gid = wgid / nig, fm = gid * WGM, gsz = (nM - fm) < WGM ? (nM - fm) : WGM;
        u.pm = fm + ((wgid % nig) % gsz); u.pn = (wgid % nig) / gsz; return true;
    }
    __device__ __forceinline__ void a_ready(const Unit&) const {}
    __device__ __forceinline__ void done(const Unit&) const {}
};

__device__ __forceinline__ unsigned cvt_pk_bf16(float lo, float hi) { unsigned r; asm volatile("v_cvt_pk_bf16_f32 %0, %1, %2" : "=v"(r) : "v"(lo), "v"(hi)); return r; }
typedef float f32x2 __attribute__((ext_vector_type(2)));
__device__ __forceinline__ f32x2 gelu_pk(f32x2 v) {
    const f32x2 av = __builtin_elementwise_abs(v), d = av * 0.2316418882f + 1.0f;
    f32x2 t; t.x = __builtin_amdgcn_rcpf(d.x); t.y = __builtin_amdgcn_rcpf(d.y);
    f32x2 q = t * 0.5307027145f + (-0.7265760135f); q = q * t + 0.7107068705f; q = q * t + (-0.142248368f); q = q * t + 0.127414796f; q = q * t;
    const f32x2 s = (v * v) * (-0.72134752044f);
    f32x2 e; e.x = __builtin_amdgcn_exp2f(s.x); e.y = __builtin_amdgcn_exp2f(s.y);
    const f32x2 m = v * (q * e), r = v - m;
    f32x2 o; o.x = v.x < 0.f ? m.x : r.x; o.y = v.y < 0.f ? m.y : r.y; return o;
}

template <int ACT  > struct EpiBf16 {
    static constexpr bool PERM = true, AFTER_DRAIN = false; static_assert(ACT == 0 || ACT == 1, "EpiBf16: ACT is 0 (none) or 1 (gelu_pk)");
    bf16_t* O; int ldc; const float* bias; int split_cols; size_t split_stride; float scale0;
    __device__ __forceinline__ void operator()(const f32x4 (&acc)[2][2][4][2], const Unit& u, int wr, int wc, int fr, int fq) const {
        const int row0 = u.pm * BM + wr * 64 + fr; int colt = u.pn * BM; bf16_t* base = O;
        float sc = 1.f; if (split_cols) { const int t = colt / split_cols; base += (size_t)t * split_stride; colt -= t * split_cols; if (t == 0) sc = scale0; }
        const int col0 = colt + wc * 32 + 8 * fq, bcol0 = u.pn * BM + wc * 32 + 8 * fq;
        f32x4 bv[2][2];
#pragma unroll
        for (int bj = 0; bj < 2; ++bj)
#pragma unroll
            for (int n = 0; n < 2; ++n) bv[bj][n] = bias ? *(const f32x4*)(bias + bcol0 + bj * HALF + 4 * n) : (f32x4){0.f, 0.f, 0.f, 0.f};
#pragma unroll
        for (int ai = 0; ai < 2; ++ai)
#pragma unroll
            for (int m = 0; m < 4; ++m) { bf16_t* rowp = base + (size_t)(row0 + ai * HALF + m * 16) * ldc + col0;
#pragma unroll
                for (int bj = 0; bj < 2; ++bj) { f32x4 v0 = acc[ai][bj][m][0] + bv[bj][0], v1 = acc[ai][bj][m][1] + bv[bj][1];
                    if (ACT == 1) { f32x2 a = gelu_pk((f32x2){v0[0], v0[1]}), b = gelu_pk((f32x2){v0[2], v0[3]}), c = gelu_pk((f32x2){v1[0], v1[1]}), d = gelu_pk((f32x2){v1[2], v1[3]});
                        v0 = (f32x4){a.x, a.y, b.x, b.y}; v1 = (f32x4){c.x, c.y, d.x, d.y}; }
                    v0 = v0 * sc; v1 = v1 * sc; u32x4 w; w.x = cvt_pk_bf16(v0[0], v0[1]); w.y = cvt_pk_bf16(v0[2], v0[3]); w.z = cvt_pk_bf16(v1[0], v1[1]); w.w = cvt_pk_bf16(v1[2], v1[3]);
                    *(u32x4*)(rowp + bj * HALF) = w; } }
    }
};
struct EpiStore {
    static constexpr bool PERM = true, AFTER_DRAIN = false;
    bf16_t* O; int ldc; int ntn;
    __device__ __forceinline__ void operator()(const f32x4 (&acc)[2][2][4][2], const Unit& u, int wr, int wc, int fr, int fq) const {
        const int row0 = u.pm * BM + wr * 64 + fr; const int col0 = (u.pn % ntn) * BM + wc * 32 + 8 * fq;
#pragma unroll
        for (int ai = 0; ai < 2; ++ai)
#pragma unroll
            for (int m = 0; m < 4; ++m) { bf16_t* rowp = O + (size_t)(row0 + ai * HALF + m * 16) * ldc + col0;
#pragma unroll
                for (int bj = 0; bj < 2; ++bj) { const f32x4 v0 = acc[ai][bj][m][0], v1 = acc[ai][bj][m][1];
                    u32x4 w; w.x = cvt_pk_bf16(v0[0], v0[1]); w.y = cvt_pk_bf16(v0[2], v0[3]); w.z = cvt_pk_bf16(v1[0], v1[1]); w.w = cvt_pk_bf16(v1[2], v1[3]);
                    *(u32x4*)(rowp + bj * HALF) = w; } }
    }
};
struct EpiResid {
    static constexpr bool PERM = false, AFTER_DRAIN = false;
    const float* base; float* out; int ldc;
    __device__ __forceinline__ void operator()(const f32x4 (&acc)[2][2][4][2], const Unit& u, int wr, int wc, int fr, int fq) const {
        const int row0 = u.pm * BM + wr * 64 + fr; const int col0 = u.pn * BM + wc * 32 + 4 * fq;
#pragma unroll
        for (int ai = 0; ai < 2; ++ai)
#pragma unroll
            for (int m = 0; m < 4; ++m) { const size_t off = (size_t)(row0 + ai * HALF + m * 16) * ldc + col0;
#pragma unroll
                for (int bj = 0; bj < 2; ++bj)
#pragma unroll
                    for (int n = 0; n < 2; ++n) { const f32x4 b = *(const f32x4*)(base + off + bj * HALF + n * 16); *(f32x4*)(out + off + bj * HALF + n * 16) = b + acc[ai][bj][m][n]; } }
    }
};
struct EpiSwiglu {
    static constexpr bool PERM = true, AFTER_DRAIN = false;
    bf16_t* O; int ldc; int ntn;
    __device__ __forceinline__ void operator()(const f32x4 (&acc)[2][2][4][2], const Unit& u, int wr, int wc, int fr, int fq) const {
        typedef unsigned u32x2v __attribute__((ext_vector_type(2)));
        const int row0 = u.pm * BM + wr * 64 + fr; const int col0 = (u.pn % ntn) * HALF + wc * 16 + 4 * fq;
#pragma unroll
        for (int ai = 0; ai < 2; ++ai)
#pragma unroll
            for (int m = 0; m < 4; ++m) { bf16_t* rowp = O + (size_t)(row0 + ai * HALF + m * 16) * ldc + col0;
#pragma unroll
                for (int bj = 0; bj < 2; ++bj) { const f32x4 g = acc[ai][bj][m][0], uu = acc[ai][bj][m][1]; float h[4];
#pragma unroll
                    for (int e = 0; e < 4; ++e) h[e] = g[e] * __builtin_amdgcn_rcpf(1.0f + __expf(-g[e])) * uu[e];
                    u32x2v w; w.x = cvt_pk_bf16(h[0], h[1]); w.y = cvt_pk_bf16(h[2], h[3]);
                    *(u32x2v*)(rowp + bj * 64) = w; } }
    }
};
struct EpiGate {
    static constexpr bool PERM = true, AFTER_DRAIN = false;
    bf16_t* O; int ldc; int ntn; const float* gate;
    __device__ __forceinline__ void operator()(const f32x4 (&acc)[2][2][4][2], const Unit& u, int wr, int wc, int fr, int fq) const {
        const int row0 = u.pm * BM + wr * 64 + fr; const int col0 = (u.pn % ntn) * BM + wc * 32 + 8 * fq;
#pragma unroll
        for (int ai = 0; ai < 2; ++ai)
#pragma unroll
            for (int m = 0; m < 4; ++m) { const int row = row0 + ai * HALF + m * 16; const float gs = gate[row]; bf16_t* rowp = O + (size_t)row * ldc + col0;
#pragma unroll
                for (int bj = 0; bj < 2; ++bj) { const f32x4 v0 = acc[ai][bj][m][0] * gs, v1 = acc[ai][bj][m][1] * gs;
                    u32x4 w; w.x = cvt_pk_bf16(v0[0], v0[1]); w.y = cvt_pk_bf16(v0[2], v0[3]); w.z = cvt_pk_bf16(v1[0], v1[1]); w.w = cvt_pk_bf16(v1[2], v1[3]);
                    *(u32x4*)(rowp + bj * HALF) = w; } }
    }
};
struct MoeOrder {
    int nN, mpe, total, G, v;
    __device__ void init(int nE, int mpe_, int nN_, int G_, int v_) { nN = nN_; mpe = mpe_; total = nE * mpe_ * nN_; G = G_; v = v_; }
    __device__ bool next(int i, Unit& u) const {
        const long L = (long)i * G + v; if (L >= total) return false;
        const int per = mpe * nN, e = (int)L / per, r = (int)L % per;
        u.pm = e * mpe + r / nN; u.pn = e * nN + r % nN; return true;
    }
    __device__ __forceinline__ void a_ready(const Unit&) const {}
    __device__ __forceinline__ void done(const Unit&) const {}
};
template <class Epi, class Sched, bool ALIGN_EPI = false, bool SP2 = false>
__device__ __forceinline__ void gemm_phase(PG8_LAS unsigned char* lds, const Gemm g, const Sched& S, const Epi& E) {
    int tid_ = threadIdx.x; asm volatile("" : "+v"(tid_));
    const int tid = tid_, wid = __builtin_amdgcn_readfirstlane(tid >> 6), lane = tid & 63, wr = wid >> 2, wc = wid & 3, fr = lane & 15, fq = lane >> 4;
    const int K = g.K, nt = K / BK;
    unsigned voffA[2], voffB[2];
#pragma unroll
    for (int i = 0; i < 2; ++i) { int R, C; stage_rc(tid * 16 + i * 8192, R, C); const int Rb = Epi::PERM ? ((R & ~31) + perm32(R & 31)) : R;
        voffA[i] = (unsigned)(R * K + C) * 2u; voffB[i] = (unsigned)(Rb * K + C) * 2u; }
    const size_t kstep = (size_t)(BK * 2);
    const size_t hstep = (size_t)HALF * K * 2;
    const size_t tstep = 2 * hstep;
    const unsigned ldsw = (unsigned)wid * 1024u;
    const int aoff = lds_byte(wr * 64 + fr, fq * 8), boff = lds_byte(wc * 32 + fr, fq * 8);
#define PG8_SA(b, h) (((b) * 2 + (h)) * HTB)
#define PG8_SB(b, h) ((4 + (b) * 2 + (h)) * HTB)
#define PG8_STAGE(bufoff, gbase, voff) do { _Pragma("unroll") for (int _i = 0; _i < 2; ++_i) \
        __builtin_amdgcn_global_load_lds((const unsigned*)((const char*)(gbase) + (voff)[_i]), (PG8_LAS unsigned*)(lds + (bufoff) + ldsw + _i * 8192), 16, 0, 0); } while (0)
#define PG8_LDA(dst, b, h) do { _Pragma("unroll") for (int m = 0; m < 4; ++m) _Pragma("unroll") for (int k = 0; k < 2; ++k) dst[m][k] = *(const PG8_LAS bf16x8*)(lds + PG8_SA(b, h) + aoff + m * 2048 + k * 1024); } while (0)
#define PG8_LDB(dst, b, h) do { _Pragma("unroll") for (int n = 0; n < 2; ++n) _Pragma("unroll") for (int k = 0; k < 2; ++k) dst[n][k] = *(const PG8_LAS bf16x8*)(lds + PG8_SB(b, h) + boff + n * 2048 + k * 1024); } while (0)
#define PG8_MMA(ai, bj, At, Bt) do { __builtin_amdgcn_s_setprio(1); _Pragma("unroll") for (int m = 0; m < 4; ++m) _Pragma("unroll") for (int n = 0; n < 2; ++n) _Pragma("unroll") for (int k = 0; k < 2; ++k) \
        acc[ai][bj][m][n] = __builtin_amdgcn_mfma_f32_16x16x32_bf16(Bt[n][k], At[m][k], acc[ai][bj][m][n], 0, 0, 0); __builtin_amdgcn_s_setprio(0); } while (0)
#define PG8_WAIT_V(n) asm volatile("s_waitcnt vmcnt(" #n ")" ::: "memory")
#define PG8_WAIT_L(n) asm volatile("s_waitcnt lgkmcnt(" #n ")" ::: "memory")
#define PG8_BAR __builtin_amdgcn_s_barrier()
#define PG8_SCHED __builtin_amdgcn_sched_barrier(0)
    Unit cur, nxt; int ui = 0;
    if (!S.next(0, cur)) return;
    f32x4 acc[2][2][4][2];
#pragma unroll
    for (int a = 0; a < 2; ++a)
#pragma unroll
        for (int b = 0; b < 2; ++b)
#pragma unroll
            for (int m = 0; m < 4; ++m)
#pragma unroll
                for (int n = 0; n < 2; ++n) acc[a][b][m][n] = (f32x4){0.f, 0.f, 0.f, 0.f};
    bf16x8 At[4][2], B0[2][2], B1[2][2];
    const char* cA = (const char*)g.A + (size_t)cur.pm * tstep; const char* cB = (const char*)g.Bt + (size_t)cur.pn * tstep;
    S.a_ready(cur);
    if constexpr (SP2) {
        PG8_STAGE(PG8_SB(0, 0), cB, voffB); PG8_STAGE(PG8_SB(0, 1), cB + hstep, voffB); PG8_STAGE(PG8_SA(0, 0), cA, voffA); PG8_STAGE(PG8_SA(0, 1), cA + hstep, voffA);
        if (wr == 1) PG8_BAR;
        PG8_WAIT_V(2); PG8_BAR;
        PG8_STAGE(PG8_SB(1, 0), cB + kstep, voffB); PG8_STAGE(PG8_SA(1, 0), cA + kstep, voffA); PG8_STAGE(PG8_SB(1, 1), cB + hstep + kstep, voffB);
        PG8_WAIT_V(6); PG8_BAR;
    } else {
        PG8_STAGE(PG8_SB(0, 0), cB, voffB); PG8_STAGE(PG8_SA(0, 0), cA, voffA); PG8_STAGE(PG8_SB(0, 1), cB + hstep, voffB); PG8_STAGE(PG8_SA(0, 1), cA + hstep, voffA);
        if (wr == 1) PG8_BAR;
        PG8_WAIT_V(4); PG8_BAR;
        PG8_STAGE(PG8_SB(1, 0), cB + kstep, voffB); PG8_STAGE(PG8_SA(1, 0), cA + kstep, voffA); PG8_STAGE(PG8_SB(1, 1), cB + hstep + kstep, voffB);
        PG8_WAIT_V(6); PG8_BAR;
    }
    for (;;) {
        const bool has_next = S.next(ui + 1, nxt);
        const char* nA = has_next ? (const char*)g.A + (size_t)nxt.pm * tstep : cA; const char* nB = has_next ? (const char*)g.Bt + (size_t)nxt.pn * tstep : cB;
        for (int t = 0; t < nt; t += 2) {
            const bool last = (t == nt - 2);
            const char* a1 = cA + (size_t)(t + 1) * kstep;
            const char* a2 = last ? nA : cA + (size_t)(t + 2) * kstep; const char* b2 = last ? nB : cB + (size_t)(t + 2) * kstep;
            const char* a3 = a2 + kstep; const char* b3 = b2 + kstep;
            if (last && has_next) S.a_ready(nxt);
            if constexpr (SP2) {
            PG8_LDB(B0, 0, 0); PG8_LDB(B1, 0, 1); PG8_SCHED; PG8_LDA(At, 0, 0); PG8_STAGE(PG8_SA(1, 1), a1 + hstep, voffA);
            PG8_WAIT_V(8); PG8_WAIT_L(0); PG8_BAR; PG8_MMA(0, 0, At, B0); PG8_MMA(0, 1, At, B1); PG8_BAR; PG8_SCHED;
            PG8_LDA(At, 0, 1); PG8_STAGE(PG8_SB(0, 0), b2, voffB); PG8_STAGE(PG8_SB(0, 1), b2 + hstep, voffB); PG8_STAGE(PG8_SA(0, 0), a2, voffA);
            PG8_WAIT_V(8); PG8_WAIT_L(0); PG8_BAR; PG8_MMA(1, 0, At, B0); PG8_MMA(1, 1, At, B1); PG8_BAR; PG8_SCHED;
            PG8_LDB(B0, 1, 0); PG8_LDB(B1, 1, 1); PG8_SCHED; PG8_LDA(At, 1, 0); PG8_STAGE(PG8_SA(0, 1), a2 + hstep, voffA);
            PG8_WAIT_V(8); PG8_WAIT_L(0); PG8_BAR; PG8_MMA(0, 0, At, B0); PG8_MMA(0, 1, At, B1); PG8_BAR; PG8_SCHED;
            PG8_LDA(At, 1, 1); PG8_STAGE(PG8_SB(1, 0), b3, voffB); PG8_STAGE(PG8_SB(1, 1), b3 + hstep, voffB); PG8_STAGE(PG8_SA(1, 0), a3, voffA);
            PG8_WAIT_V(8); PG8_WAIT_L(0); PG8_BAR; PG8_MMA(1, 0, At, B0); PG8_MMA(1, 1, At, B1); PG8_BAR; PG8_SCHED;
            } else {
            PG8_LDB(B0, 0, 0); PG8_SCHED; PG8_LDA(At, 0, 0); PG8_STAGE(PG8_SA(1, 1), a1 + hstep, voffA);
            PG8_WAIT_L(8); PG8_BAR; PG8_WAIT_L(0); PG8_MMA(0, 0, At, B0); PG8_BAR; PG8_SCHED;
            PG8_LDB(B1, 0, 1); PG8_STAGE(PG8_SB(0, 0), b2, voffB);
            PG8_BAR; PG8_WAIT_L(0); PG8_MMA(0, 1, At, B1); PG8_BAR;
            PG8_LDA(At, 0, 1); PG8_STAGE(PG8_SA(0, 0), a2, voffA);
            PG8_BAR; PG8_WAIT_L(0); PG8_MMA(1, 0, At, B0); PG8_BAR; PG8_SCHED;
            PG8_STAGE(PG8_SB(0, 1), b2 + hstep, voffB);
            PG8_WAIT_V(6); PG8_BAR; PG8_MMA(1, 1, At, B1); PG8_BAR;
            PG8_LDB(B0, 1, 0); PG8_SCHED; PG8_LDA(At, 1, 0); PG8_STAGE(PG8_SA(0, 1), a2 + hstep, voffA);
            PG8_WAIT_L(8); PG8_BAR; PG8_WAIT_L(0); PG8_MMA(0, 0, At, B0); PG8_BAR; PG8_SCHED;
            PG8_LDB(B1, 1, 1); PG8_STAGE(PG8_SB(1, 0), b3, voffB);
            PG8_BAR; PG8_WAIT_L(0); PG8_MMA(0, 1, At, B1); PG8_BAR;
            PG8_LDA(At, 1, 1); PG8_STAGE(PG8_SA(1, 0), a3, voffA);
            PG8_BAR; PG8_WAIT_L(0); PG8_MMA(1, 0, At, B0); PG8_BAR; PG8_SCHED;
            PG8_STAGE(PG8_SB(1, 1), b3 + hstep, voffB);
            PG8_WAIT_V(6); PG8_BAR; PG8_MMA(1, 1, At, B1); PG8_BAR;
            }
        }
        if constexpr (ALIGN_EPI) { if (wr == 0) PG8_BAR; }
        if constexpr (!Epi::AFTER_DRAIN) { E(acc, cur, wr, wc, fr, fq); S.done(cur); }
        if (!has_next) break;
#pragma unroll
        for (int a = 0; a < 2; ++a)
#pragma unroll
            for (int b = 0; b < 2; ++b)
#pragma unroll
                for (int m = 0; m < 4; ++m)
#pragma unroll
                    for (int n = 0; n < 2; ++n) acc[a][b][m][n] = (f32x4){0.f, 0.f, 0.f, 0.f};
        cur = nxt; cA = nA; cB = nB; ++ui;
        if constexpr (ALIGN_EPI) { if (wr == 1) PG8_BAR; }
    }
    PG8_WAIT_V(0);
    if constexpr (!ALIGN_EPI) { if (wr == 0) PG8_BAR; }
    PG8_BAR;
    if constexpr (Epi::AFTER_DRAIN) { E.fused(acc, cur, wr, wc, fr, fq, lds, wid, lane); S.done(cur); }
#undef PG8_SA
#undef PG8_SB
#undef PG8_STAGE
#undef PG8_LDA
#undef PG8_LDB
#undef PG8_MMA
#undef PG8_WAIT_V
#undef PG8_WAIT_L
#undef PG8_BAR
#undef PG8_SCHED
}
}
#define GAS __attribute__((address_space(1)))
#define LAS __attribute__((address_space(3)))
typedef unsigned short bf16;
typedef unsigned v4u __attribute__((ext_vector_type(4)));
typedef float f32x4 __attribute__((ext_vector_type(4)));
typedef short bf16x8 __attribute__((ext_vector_type(8)));
typedef GAS unsigned gu32;
typedef GAS unsigned long long gu64;
#define RLX_AGENT __ATOMIC_RELAXED, __HIP_MEMORY_SCOPE_AGENT
#define LDS_WAIT() asm volatile("s_waitcnt lgkmcnt(0)" ::: "memory")
#define VM_WAIT() asm volatile("s_waitcnt vmcnt(0)" ::: "memory")
__device__ __forceinline__ unsigned long long rt() { return __builtin_amdgcn_s_memrealtime(); }
__device__ __forceinline__ unsigned f2bf(float f) { unsigned u = __builtin_bit_cast(unsigned, f); return (u + 0x7fffu + ((u >> 16) & 1u)) >> 16; }
__device__ __forceinline__ unsigned pk2(float lo, float hi) { return f2bf(lo) | (f2bf(hi) << 16); }
#define XB_TMO      128
#define XB_XCNT(j)  (256  + 64 * (j))
#define XB_XSUB(j)  (1280 + 64 * (j))
#define XB_XGEN(j)  (2304 + 64 * (j))
#define XB_TOP      3328
#define XB_TOPGEN   3392
#define XCD_BAR_WORDS 3456
#define XB_SPIN_CAP (1u << 18)

__device__ __forceinline__ unsigned xb_ld(unsigned* p)              { return __hip_atomic_load(p, __ATOMIC_RELAXED, __HIP_MEMORY_SCOPE_AGENT); }
__device__ __forceinline__ unsigned xb_add(unsigned* p, unsigned v) { return __hip_atomic_fetch_add(p, v, __ATOMIC_RELAXED, __HIP_MEMORY_SCOPE_AGENT); }
__device__ __forceinline__ unsigned xb_xcc_id() { return (unsigned)__builtin_amdgcn_s_getreg((3 << 11) | 20) & 0xFu; }
#define XB_SPIN(cond, bar) do { unsigned _sp = 0; while (cond) { __builtin_amdgcn_s_sleep(1); \
    if ((++_sp & 255u) == 0u) { if (xb_ld(&(bar)[XB_TMO])) break; if (_sp > XB_SPIN_CAP) { atomicAdd(&(bar)[XB_TMO], 1u); break; } } } } while (0)

struct XcdBarrier {
    unsigned* bar; unsigned x;
    volatile LAS unsigned* st;
};

__device__ __forceinline__ XcdBarrier xcd_barrier_post(unsigned* bar, volatile LAS unsigned* st) {
    XcdBarrier b; b.bar = bar; b.x = xb_xcc_id(); b.st = st;
    if (threadIdx.x == 0) (void)xb_add(&bar[XB_XCNT(b.x)], 1u);
    return b;
}
__device__ __forceinline__ void xcd_barrier_complete(unsigned* bar, unsigned x, unsigned& nloc, unsigned& nx) {
    const unsigned G = gridDim.x * gridDim.y * gridDim.z;
    unsigned sum, cnt, mine, sp = 0u;
    for (;;) {
        sum = 0u; cnt = 0u; mine = 0u;
#pragma unroll
        for (unsigned j = 0; j < 16; ++j) { const unsigned c = xb_ld(&bar[XB_XCNT(j)]); sum += c; cnt += (c > 0u) ? 1u : 0u; mine = (j == x) ? c : mine; }
        if (sum == G) break;
        __builtin_amdgcn_s_sleep(1);
        if ((++sp & 255u) == 0u) { if (xb_ld(&bar[XB_TMO])) break; if (sp > XB_SPIN_CAP) { atomicAdd(&bar[XB_TMO], 1u); break; } }
    }
    nloc = mine > 0u ? mine : 1u; nx = cnt > 0u ? cnt : 1u;
}

__device__ __forceinline__ void xcd_barrier(const XcdBarrier& b) {
    asm volatile("s_waitcnt vmcnt(0)" ::: "memory");
    __syncthreads();
    if (threadIdx.x == 0) {
        unsigned* bar = b.bar;
        __builtin_amdgcn_s_waitcnt(0);
        unsigned nloc = b.st[0], nx = b.st[1];
        if (nloc == 0u) { xcd_barrier_complete(bar, b.x, nloc, nx); b.st[0] = nloc; b.st[1] = nx; }
        const unsigned old = xb_add(&bar[XB_XSUB(b.x)], 1u);
        const unsigned gen = old / nloc;
        if (old + 1u == (gen + 1u) * nloc) {
            __builtin_amdgcn_fence(__ATOMIC_RELEASE, "agent");
            asm volatile("s_waitcnt vmcnt(0)" ::: "memory");
            const unsigned og = xb_add(&bar[XB_TOP], 1u);
            const unsigned tg = og / nx;
            if (og + 1u == (tg + 1u) * nx) xb_add(&bar[XB_TOPGEN], 1u);
            else XB_SPIN(xb_ld(&bar[XB_TOPGEN]) == tg, bar);
            __builtin_amdgcn_fence(__ATOMIC_ACQUIRE, "agent");
            xb_add(&bar[XB_XGEN(b.x)], 1u);
            asm volatile("s_waitcnt vmcnt(0)" ::: "memory");
        } else {
            XB_SPIN(xb_ld(&bar[XB_XGEN(b.x)]) == gen, bar);
            __builtin_amdgcn_fence(__ATOMIC_ACQUIRE, "agent");
            asm volatile("s_waitcnt vmcnt(0)" ::: "memory");
        }
    }
    __syncthreads();
}
constexpr int NWAVES = 8;
constexpr int BATCH = 16, SEQ = 2048, D = 1024, M = BATCH * SEQ, NH = 16, HD = 64, NE = 16, CAP = 256, DFF = 2048, NSLOT = BATCH * NE * CAP, NLAYER = 4;
constexpr float EPS = 1e-6f;
constexpr int N_IN = 28;
enum { I_X = 0, I_GMIX, I_GFFN, I_NA_WQKV, I_NA_QN, I_NA_KN, I_NA_RPB, I_NA_WOUT, I_DF_WQKV, I_DF_QN, I_DF_KN, I_DF_LQ1, I_DF_LK1, I_DF_LQ2, I_DF_LK2, I_DF_SUB, I_DF_WOUT,
       I_SC_WIN, I_SC_CONV, I_SC_WOUT, I_DL_WQKV, I_DL_QN, I_DL_KN, I_DL_WOUT, I_ROUTER, I_WGATE, I_WUP, I_WDOWN };
constexpr size_t MiB = 1u << 20;
constexpr size_t WS_CTL = 0, CTL_ZERO_BYTES = 1 * MiB;
constexpr size_t WS_AFFT = 2 * MiB;
constexpr size_t WS_IDX = 4 * MiB;
constexpr size_t WS_GATE = 4 * MiB + 512 * 1024;
constexpr size_t WS_SLOTOF = 6 * MiB;
constexpr size_t WS_LSE = 8 * MiB;
constexpr size_t WS_ROPE = 15 * MiB;
constexpr size_t WS_WQKV = 16 * MiB;
constexpr size_t WS_WOUT = 52 * MiB;
constexpr size_t WS_WGU = 64 * MiB;
constexpr size_t WS_WDN = 576 * MiB;
constexpr size_t WS_HN = 832 * MiB;
constexpr size_t WS_QKV = 896 * MiB;
constexpr size_t WS_XIN = 896 * MiB;
constexpr size_t WS_HMID = 1024 * MiB;
constexpr size_t WS_Y = 1280 * MiB;
constexpr size_t WS_O = 1472 * MiB;
constexpr size_t WS_OG = 1536 * MiB;
constexpr size_t WS_END = 1792 * MiB;
__host__ __device__ constexpr size_t wqkv_off(int L) { return WS_WQKV + (size_t)L * 6 * MiB; }
constexpr int CW_TMO = 0, CW_CODE = 1, CW_BAR = 4096;
constexpr int RING_OFF = 0, RING_BYTES = 131072;
constexpr int LDSCTL_OFF = RING_BYTES, MISC_OFF = LDSCTL_OFF + 320;
constexpr int LDS_BYTES = 147456;

struct Args { const float* in[N_IN]; float* out; unsigned char* ws; int ph_lo, ph_hi, li, pad; };
struct Frame {
    LAS unsigned char* lds;
    volatile LAS unsigned* MISC;
    gu32* ctl;
    int tid, lane, wave, vcu, G, gw, NGW;
    float* out; unsigned char* ws;
};
__device__ __forceinline__ int opq(int v) { asm volatile("" : "+v"(v)); return v; }
__device__ __forceinline__ float wave_sum(float v) {
#pragma unroll
    for (int o = 1; o < 64; o <<= 1) v += __shfl_xor(v, o);
    return v;
}
__device__ __forceinline__ float bflo(unsigned u) { return __uint_as_float(u << 16); }
__device__ __forceinline__ float bfhi(unsigned u) { return __uint_as_float(u & 0xffff0000u); }
__device__ __forceinline__ void unpack8(const v4u w, float (&x)[8]) { x[0] = bflo(w.x); x[1] = bfhi(w.x); x[2] = bflo(w.y); x[3] = bfhi(w.y); x[4] = bflo(w.z); x[5] = bfhi(w.z); x[6] = bflo(w.w); x[7] = bfhi(w.w); }
__device__ __forceinline__ v4u pack8(const float (&x)[8]) { v4u w; w.x = pk2(x[0], x[1]); w.y = pk2(x[2], x[3]); w.z = pk2(x[4], x[5]); w.w = pk2(x[6], x[7]); return w; }

__device__ __forceinline__ void tr_item(const float* srcl, size_t ldn, int k0, bf16* WT, int K, int drow0, LAS float* scr, int lane) {
#pragma unroll 8
    for (int i = 0; i < 32; ++i) { const int kk = 2 * i + (lane >> 5); scr[kk * 33 + (lane & 31)] = srcl[(size_t)(k0 + kk) * ldn]; }
    LDS_WAIT(); asm volatile("" ::: "memory");
    const int c = lane & 7;
#pragma unroll
    for (int j = 0; j < 4; ++j) { const int n = (lane >> 3) + 8 * j; const LAS float* s = scr + (8 * c) * 33 + n;
        v4u o; o.x = pk2(s[0 * 33], s[1 * 33]); o.y = pk2(s[2 * 33], s[3 * 33]); o.z = pk2(s[4 * 33], s[5 * 33]); o.w = pk2(s[6 * 33], s[7 * 33]);
        *(GAS v4u*)(WT + (size_t)(drow0 + n) * K + k0 + 8 * c) = o; }
    LDS_WAIT(); asm volatile("" ::: "memory");
}
__device__ __forceinline__ void tr_plain(const float* W, int K, int N, bf16* WT, int item, LAS float* scr, int lane) {
    const int nblk = N / 32, kb = item / nblk, nb = item % nblk;
    tr_item(W + 32 * nb + (lane & 31), (size_t)N, 64 * kb, WT, K, 32 * nb, scr, lane);
}
__device__ __forceinline__ void rms_apply(f32x4 (&v)[4], const f32x4 (&gg)[4]) {
    float s = 0.f;
#pragma unroll
    for (int j = 0; j < 4; ++j) s += (v[j].x * v[j].x + v[j].y * v[j].y) + (v[j].z * v[j].z + v[j].w * v[j].w);
    const float rstd = 1.0f / sqrtf(wave_sum(s) * (1.f / D) + EPS);
#pragma unroll
    for (int j = 0; j < 4; ++j) v[j] = v[j] * rstd * gg[j];
}
__device__ __forceinline__ void store_row_bf16(bf16* orow, int lane, const f32x4 (&v)[4]) {
    GAS unsigned long long* o8 = (GAS unsigned long long*)orow + lane;
#pragma unroll
    for (int j = 0; j < 4; ++j) o8[64 * j] = (unsigned long long)pk2(v[j].x, v[j].y) | ((unsigned long long)pk2(v[j].z, v[j].w) << 32);
}
__device__ __forceinline__ void p0_prologue(Frame& F, const Args& A) {
    LAS float* scr = (LAS float*)(F.lds + RING_OFF + F.wave * 16384);
    const float* wgate = A.in[I_WGATE]; const float* wup = A.in[I_WUP]; const float* wdown = A.in[I_WDOWN];
    bf16* WGU = (bf16*)(F.ws + WS_WGU); bf16* WDN = (bf16*)(F.ws + WS_WDN);
    constexpr int N_GU = 64 * 2048, N_DN = 64 * 1024, N_Q = 1536, N_Q3 = 4608, N_O = 512;
    constexpr int NITEMS = N_GU + N_DN + 3 * N_Q + N_Q3 + 4 * N_O;
    const int lane = opq(F.lane);
    for (int it = F.gw; it < NITEMS; it += F.NGW) {
        int r = it;
        if (r < N_GU) { const int le = r >> 11, rr = r & 2047, kb = rr >> 7, nb = rr & 127, i = lane & 31, n0 = 32 * nb;
            const float* src = (((i >> 2) & 1) ? wup : wgate) + (size_t)le * (1024 * 2048) + (n0 >> 1) + 4 * (i >> 3) + (i & 3);
            tr_item(src, 2048, 64 * kb, WGU + (size_t)le * (4096 * 1024), 1024, n0, scr, lane); continue; }
        r -= N_GU;
        if (r < N_DN) { const int le = r >> 10, rr = r & 1023, kb = rr >> 5, nb = rr & 31;
            tr_item(wdown + (size_t)le * (2048 * 1024) + 32 * nb + (lane & 31), 1024, 64 * kb, WDN + (size_t)le * (1024 * 2048), 2048, 32 * nb, scr, lane); continue; }
        r -= N_DN;
        if (r < N_Q) { tr_plain(A.in[I_NA_WQKV], 1024, 3072, (bf16*)(F.ws + wqkv_off(0)), r, scr, lane); continue; } r -= N_Q;
        if (r < N_Q) { tr_plain(A.in[I_DF_WQKV], 1024, 3072, (bf16*)(F.ws + wqkv_off(1)), r, scr, lane); continue; } r -= N_Q;
        if (r < N_Q) { tr_plain(A.in[I_SC_WIN], 1024, 3072, (bf16*)(F.ws + wqkv_off(2)), r, scr, lane); continue; } r -= N_Q;
        if (r < N_Q3) { tr_plain(A.in[I_DL_WQKV], 1024, 9216, (bf16*)(F.ws + wqkv_off(3)), r, scr, lane); continue; } r -= N_Q3;
        if (r < N_O) { tr_plain(A.in[I_NA_WOUT], 1024, 1024, (bf16*)(F.ws + WS_WOUT + 0 * 2 * MiB), r, scr, lane); continue; } r -= N_O;
        if (r < N_O) { tr_plain(A.in[I_DF_WOUT], 1024, 1024, (bf16*)(F.ws + WS_WOUT + 1 * 2 * MiB), r, scr, lane); continue; } r -= N_O;
        if (r < N_O) { tr_plain(A.in[I_SC_WOUT], 1024, 1024, (bf16*)(F.ws + WS_WOUT + 2 * 2 * MiB), r, scr, lane); continue; } r -= N_O;
        tr_plain(A.in[I_DL_WOUT], 1024, 1024, (bf16*)(F.ws + WS_WOUT + 3 * 2 * MiB), r, scr, lane);
    }
    { float2* rope = (float2*)(F.ws + WS_ROPE);
      for (int idx = blockIdx.x * (NWAVES * 64) + opq(F.tid); idx < SEQ * 32; idx += F.G * NWAVES * 64) { const int pos = idx >> 5, j = idx & 31;
          const float invf = exp2f(-(float)j * 0.41524101186092029f); const float af = (float)pos * invf;
          const double a = (double)af; const double n = rint(a * 0.15915494309189535); const float rf = (float)(a - n * 6.283185307179586);
          rope[idx] = make_float2(__cosf(rf), __sinf(rf)); } }
    { const float* g = A.in[I_GMIX]; f32x4 gg[4];
#pragma unroll
      for (int j = 0; j < 4; ++j) gg[j] = ((const GAS f32x4*)g)[lane + 64 * j];
      bf16* HN = (bf16*)(F.ws + WS_HN); const float* x = A.in[I_X];
      for (int m = F.gw; m < M; m += F.NGW) { const GAS f32x4* xr = (const GAS f32x4*)(x + (size_t)m * D) + lane; f32x4 v[4];
#pragma unroll
          for (int j = 0; j < 4; ++j) v[j] = xr[64 * j];
          rms_apply(v, gg); store_row_bf16(HN + (size_t)m * D, lane, v); } }
}

__device__ __forceinline__ void prep_phase(Frame& F, bf16* buf, int ld, int ng, const float* qg, const float* kg, bool use_rope) {
    const int lane = opq(F.lane), c = lane & 7, nch = 4 * ng; const long total = (long)M * nch;
    const float2* rope = (const float2*)(F.ws + WS_ROPE);
    float gq[8], gk[8];
#pragma unroll
    for (int i = 0; i < 8; ++i) { gq[i] = qg[c * 8 + i]; gk[i] = kg[c * 8 + i]; }
    for (long it = F.gw; it < total; it += F.NGW) {
        const int tok = (int)(it / nch), ch = (int)(it % nch), g = ch >> 2, part = (ch >> 1) & 1, half = ch & 1;
        bf16* p = buf + (size_t)tok * ld + g * 3072 + part * 1024 + half * 512 + lane * 8;
        const v4u w = *(const GAS v4u*)p; float x[8]; unpack8(w, x);
        float ss = 0.f;
#pragma unroll
        for (int i = 0; i < 8; ++i) ss += x[i] * x[i];
        ss += __shfl_xor(ss, 1); ss += __shfl_xor(ss, 2); ss += __shfl_xor(ss, 4);
        const float rstd = 1.0f / sqrtf(ss * (1.f / 64.f) + EPS);
        float y[8];
#pragma unroll
        for (int i = 0; i < 8; ++i) y[i] = x[i] * rstd * (part ? gk[i] : gq[i]);
        if (use_rope) { const int pos = tok & (SEQ - 1); const float2* rp = rope + pos * 32 + 8 * (c & 3);
#pragma unroll
            for (int i = 0; i < 8; ++i) { const float py = __shfl_xor(y[i], 4); const float2 cs = rp[i];
                y[i] = (c < 4) ? (y[i] * cs.x - py * cs.y) : (y[i] * cs.x + py * cs.y); } }
        if (part == 0) {
#pragma unroll
            for (int i = 0; i < 8; ++i) y[i] *= 0.125f; }
        *(GAS v4u*)p = pack8(y);
    }
}

__device__ __forceinline__ void na_naive(Frame& F, const bf16* QKV, const float* rpb, bf16* O) {
    const long total = (long)M * NH;
    for (long it = (long)blockIdx.x * (NWAVES * 64) + opq(F.tid); it < total; it += (long)F.G * NWAVES * 64) {
        const int h = (int)(it & 15), tok = (int)(it >> 4), b = tok >> 11, s = tok & 2047, r = s >> 6, c = s & 63;
        const int r0 = min(max(r - 4, 0), 24), cs = min(max(c - 8, 0), 48);
        float q[64], o[64];
        { const GAS v4u* qp = (const GAS v4u*)(QKV + (size_t)tok * 3072 + h * 64);
#pragma unroll
          for (int i = 0; i < 8; ++i) { float t[8]; unpack8(qp[i], t);
#pragma unroll
              for (int e = 0; e < 8; ++e) q[8 * i + e] = t[e]; } }
#pragma unroll
        for (int d = 0; d < 64; ++d) o[d] = 0.f;
        float mx = -1e30f, l = 0.f;
        for (int i = 0; i < 8; ++i) for (int jc = 0; jc < 16; ++jc) {
            const int kt = b * SEQ + (r0 + i) * 64 + cs + jc;
            const GAS v4u* kp = (const GAS v4u*)(QKV + (size_t)kt * 3072 + 1024 + h * 64);
            float sc = 0.f;
#pragma unroll
            for (int ii = 0; ii < 8; ++ii) { float t[8]; unpack8(kp[ii], t);
#pragma unroll
                for (int e = 0; e < 8; ++e) sc += q[8 * ii + e] * t[e]; }
            sc += rpb[(h * 15 + (r0 + i - r + 7)) * 31 + (cs + jc - c + 15)];
            const float mn = fmaxf(mx, sc), al = __expf(mx - mn), pp = __expf(sc - mn);
            l = l * al + pp; mx = mn;
            const GAS v4u* vp = (const GAS v4u*)(QKV + (size_t)kt * 3072 + 2048 + h * 64);
#pragma unroll
            for (int ii = 0; ii < 8; ++ii) { float t[8]; unpack8(vp[ii], t);
#pragma unroll
                for (int e = 0; e < 8; ++e) o[8 * ii + e] = o[8 * ii + e] * al + pp * t[e]; }
        }
        const float rl = 1.0f / l;
        GAS v4u* op = (GAS v4u*)(O + (size_t)tok * D + h * 64);
#pragma unroll
        for (int i = 0; i < 8; ++i) { float t[8];
#pragma unroll
            for (int e = 0; e < 8; ++e) t[e] = o[8 * i + e] * rl;
            op[i] = pack8(t); }
    }
}
__device__ __forceinline__ void diff_naive_a(Frame& F, const bf16* QKV, float* T2) {
    for (int u = blockIdx.x; u < 16 * 16 * 2 * 4; u += F.G) {
        const int qblk = u & 3, vhalf = (u >> 2) & 1, hh = (u >> 3) & 15, b = u >> 7, h8 = hh >> 1, c = hh & 1;
        const int tok = b * SEQ + qblk * 512 + opq(F.tid);
        float q[64], o[64];
        { const GAS v4u* qp = (const GAS v4u*)(QKV + (size_t)tok * 3072 + hh * 64);
#pragma unroll
          for (int i = 0; i < 8; ++i) { float t[8]; unpack8(qp[i], t);
#pragma unroll
              for (int e = 0; e < 8; ++e) q[8 * i + e] = t[e]; } }
#pragma unroll
        for (int d = 0; d < 64; ++d) o[d] = 0.f;
        float mx = -1e30f, l = 0.f;
        const bf16* kbase = QKV + (size_t)(b * SEQ) * 3072 + 1024 + hh * 64;
        const bf16* vbase = QKV + (size_t)(b * SEQ) * 3072 + 2048 + h8 * 128 + vhalf * 64;
        for (int kt = 0; kt < SEQ; ++kt) {
            const GAS v4u* kp = (const GAS v4u*)(kbase + (size_t)kt * 3072);
            float sc = 0.f;
#pragma unroll
            for (int ii = 0; ii < 8; ++ii) { float t[8]; unpack8(kp[ii], t);
#pragma unroll
                for (int e = 0; e < 8; ++e) sc += q[8 * ii + e] * t[e]; }
            if (sc > mx) { const float al = __expf(mx - sc); l *= al;
#pragma unroll
                for (int d = 0; d < 64; ++d) o[d] *= al;
                mx = sc; }
            const float pp = __expf(sc - mx); l += pp;
            const GAS v4u* vp = (const GAS v4u*)(vbase + (size_t)kt * 3072);
#pragma unroll
            for (int ii = 0; ii < 8; ++ii) { float t[8]; unpack8(vp[ii], t);
#pragma unroll
                for (int e = 0; e < 8; ++e) o[8 * ii + e] += pp * t[e]; }
        }
        const float rl = 1.0f / l;
        GAS f32x4* op = (GAS f32x4*)(T2 + ((size_t)c * M + tok) * D + h8 * 128 + vhalf * 64);
#pragma unroll
        for (int i = 0; i < 16; ++i) op[i] = (f32x4){o[4 * i] * rl, o[4 * i + 1] * rl, o[4 * i + 2] * rl, o[4 * i + 3] * rl};
    }
}
__device__ __forceinline__ void diff_naive_b(Frame& F, const Args& A, const float* T2, bf16* O, float lambda_init) {
    const int lane = opq(F.lane);
    const float d1 = wave_sum(A.in[I_DF_LQ1][lane] * A.in[I_DF_LK1][lane]), d2 = wave_sum(A.in[I_DF_LQ2][lane] * A.in[I_DF_LK2][lane]);
    const float lam = expf(d1) - expf(d2) + lambda_init;
    float sg[16];
#pragma unroll
    for (int i = 0; i < 16; ++i) sg[i] = A.in[I_DF_SUB][(lane & 7) * 16 + i] * (1.0f - lambda_init);
    for (int m = F.gw; m < M; m += F.NGW) {
        const GAS f32x4* a = (const GAS f32x4*)(T2 + (size_t)m * D + lane * 16); const GAS f32x4* bq = (const GAS f32x4*)(T2 + ((size_t)M + m) * D + lane * 16);
        float o[16]; float ss = 0.f;
#pragma unroll
        for (int i = 0; i < 4; ++i) { const f32x4 x = a[i], y = bq[i];
#pragma unroll
            for (int e = 0; e < 4; ++e) { const float v = x[e] - lam * y[e]; o[4 * i + e] = v; ss += v * v; } }
        ss += __shfl_xor(ss, 1); ss += __shfl_xor(ss, 2); ss += __shfl_xor(ss, 4);
        const float rstd = 1.0f / sqrtf(ss * (1.f / 128.f) + EPS);
        float t0[8], t1[8];
#pragma unroll
        for (int i = 0; i < 8; ++i) { t0[i] = o[i] * rstd * sg[i]; t1[i] = o[8 + i] * rstd * sg[8 + i]; }
        GAS v4u* op = (GAS v4u*)(O + (size_t)m * D + lane * 16); op[0] = pack8(t0); op[1] = pack8(t1);
    }
}
__device__ __forceinline__ void conv_naive(Frame& F, const bf16* QKV, const float* cw, bf16* O) {
    const int lane = opq(F.lane);
    float w0[16], w1[16], w2[16];
#pragma unroll
    for (int i = 0; i < 16; ++i) { w0[i] = cw[lane * 16 + i]; w1[i] = cw[1024 + lane * 16 + i]; w2[i] = cw[2048 + lane * 16 + i]; }
    for (int m = F.gw; m < M; m += F.NGW) {
        const int s = m & (SEQ - 1);
        float acc[16];
#pragma unroll
        for (int i = 0; i < 16; ++i) acc[i] = 0.f;
#pragma unroll
        for (int w = 0; w < 3; ++w) { const int ss = s + w - 1; if (ss < 0 || ss >= SEQ) continue;
            const bf16* row = QKV + (size_t)(m + w - 1) * 3072 + lane * 16;
#pragma unroll
            for (int hf = 0; hf < 2; ++hf) { float cc[8], uu[8]; unpack8(*(const GAS v4u*)(row + 1024 + hf * 8), cc); unpack8(*(const GAS v4u*)(row + 2048 + hf * 8), uu);
#pragma unroll
                for (int e = 0; e < 8; ++e) { const float z = cc[e] * uu[e]; const float wv = (w == 0) ? w0[hf * 8 + e] : (w == 1) ? w1[hf * 8 + e] : w2[hf * 8 + e]; acc[hf * 8 + e] += wv * z; } } }
        const bf16* row = QKV + (size_t)m * 3072 + lane * 16;
#pragma unroll
        for (int hf = 0; hf < 2; ++hf) { float bb[8], t[8]; unpack8(*(const GAS v4u*)(row + hf * 8), bb);
#pragma unroll
            for (int e = 0; e < 8; ++e) t[e] = bb[e] * acc[hf * 8 + e];
            *(GAS v4u*)(O + (size_t)m * D + lane * 16 + hf * 8) = pack8(t); }
    }
}
__device__ __forceinline__ void dil_naive(Frame& F, const bf16* QKV, bf16* OG, float* LSE) {
    const long total = (long)3 * M * NH;
    for (long it = (long)blockIdx.x * (NWAVES * 64) + opq(F.tid); it < total; it += (long)F.G * NWAVES * 64) {
        const int h = (int)(it & 15), tok = (int)((it >> 4) & (M - 1)), g = (int)(it >> 19), s = tok & 2047;
        const int dsh = 2 * g, dil = 1 << dsh, j = s >> dsh, L = SEQ >> dsh;
        float q[64], o[64];
        { const GAS v4u* qp = (const GAS v4u*)(QKV + (size_t)tok * 9216 + g * 3072 + h * 64);
#pragma unroll
          for (int i = 0; i < 8; ++i) { float t[8]; unpack8(qp[i], t);
#pragma unroll
              for (int e = 0; e < 8; ++e) q[8 * i + e] = t[e]; } }
#pragma unroll
        for (int d = 0; d < 64; ++d) o[d] = 0.f;
        float mx = -1e30f, l = 0.f;
        for (int dd = -64; dd <= 64; ++dd) {
            const int jj = j + dd; if (jj < 0 || jj >= L) continue;
            const int kt = tok + dd * dil;
            const GAS v4u* kp = (const GAS v4u*)(QKV + (size_t)kt * 9216 + g * 3072 + 1024 + h * 64);
            float sc = 0.f;
#pragma unroll
            for (int ii = 0; ii < 8; ++ii) { float t[8]; unpack8(kp[ii], t);
#pragma unroll
                for (int e = 0; e < 8; ++e) sc += q[8 * ii + e] * t[e]; }
            const float mn = fmaxf(mx, sc), al = __expf(mx - mn), pp = __expf(sc - mn);
            l = l * al + pp; mx = mn;
            const GAS v4u* vp = (const GAS v4u*)(QKV + (size_t)kt * 9216 + g * 3072 + 2048 + h * 64);
#pragma unroll
            for (int ii = 0; ii < 8; ++ii) { float t[8]; unpack8(vp[ii], t);
#pragma unroll
                for (int e = 0; e < 8; ++e) o[8 * ii + e] = o[8 * ii + e] * al + pp * t[e]; }
        }
        const float rl = 1.0f / l;
        GAS v4u* op = (GAS v4u*)(OG + ((size_t)g * M + tok) * D + h * 64);
#pragma unroll
        for (int i = 0; i < 8; ++i) { float t[8];
#pragma unroll
            for (int e = 0; e < 8; ++e) t[e] = o[8 * i + e] * rl;
            op[i] = pack8(t); }
        LSE[((size_t)g * M + tok) * 16 + h] = mx + __logf(l);
    }
}
__device__ __forceinline__ void dil_merge(Frame& F, const bf16* OG, const float* LSE, bf16* O) {
    const int lane = opq(F.lane), h = lane >> 2;
    for (int m = F.gw; m < M; m += F.NGW) {
        const float l0 = LSE[(size_t)m * 16 + h], l1 = LSE[((size_t)M + m) * 16 + h], l2 = LSE[((size_t)2 * M + m) * 16 + h];
        const float mx = fmaxf(l0, fmaxf(l1, l2)); float a0 = __expf(l0 - mx), a1 = __expf(l1 - mx), a2 = __expf(l2 - mx); const float rs = 1.0f / (a0 + a1 + a2); a0 *= rs; a1 *= rs; a2 *= rs;
#pragma unroll
        for (int hf = 0; hf < 2; ++hf) { float x0[8], x1[8], x2[8], t[8];
            unpack8(*(const GAS v4u*)(OG + (size_t)m * D + lane * 16 + hf * 8), x0); unpack8(*(const GAS v4u*)(OG + ((size_t)M + m) * D + lane * 16 + hf * 8), x1); unpack8(*(const GAS v4u*)(OG + ((size_t)2 * M + m) * D + lane * 16 + hf * 8), x2);
#pragma unroll
            for (int e = 0; e < 8; ++e) t[e] = a0 * x0[e] + a1 * x1[e] + a2 * x2[e];
            *(GAS v4u*)(O + (size_t)m * D + lane * 16 + hf * 8) = pack8(t); }
    }
}

__device__ __forceinline__ void norm2_router(Frame& F, const Args& A, int L) {
    const int lane = opq(F.lane); LAS float* wl = (LAS float*)(F.lds + RING_OFF);
    const float* wr = A.in[I_ROUTER] + (size_t)L * D * NE;
    for (int idx = opq(F.tid); idx < D * NE; idx += NWAVES * 64) wl[(idx & 15) * 1024 + (idx >> 4)] = wr[idx];
    __syncthreads();
    const float* g = A.in[I_GFFN] + (size_t)L * D; f32x4 gg[4];
#pragma unroll
    for (int j = 0; j < 4; ++j) gg[j] = ((const GAS f32x4*)g)[lane + 64 * j];
    bf16* HN = (bf16*)(F.ws + WS_HN); float* AFFT = (float*)(F.ws + WS_AFFT); const float* x = F.out;
    for (int m = F.gw; m < M; m += F.NGW) {
        const GAS f32x4* xr = (const GAS f32x4*)(x + (size_t)m * D) + lane; f32x4 v[4];
#pragma unroll
        for (int j = 0; j < 4; ++j) v[j] = xr[64 * j];
        rms_apply(v, gg); store_row_bf16(HN + (size_t)m * D, lane, v);
        float mylg = 0.f;
#pragma unroll 2
        for (int e = 0; e < 16; ++e) { float a = 0.f;
#pragma unroll
            for (int j = 0; j < 4; ++j) { const f32x4 w4 = *(const LAS f32x4*)(wl + e * 1024 + 256 * j + 4 * lane); a += (v[j].x * w4.x + v[j].y * w4.y) + (v[j].z * w4.z + v[j].w * w4.w); }
            a = wave_sum(a); mylg = (lane == e) ? a : mylg; }
        float mx = mylg;
#pragma unroll
        for (int o = 1; o < 16; o <<= 1) mx = fmaxf(mx, __shfl_xor(mx, o));
        const float val = expf(mylg - mx); float sum = val;
#pragma unroll
        for (int o = 1; o < 16; o <<= 1) sum += __shfl_xor(sum, o);
        if (lane < 16) AFFT[((size_t)(m >> 11) * 16 + lane) * SEQ + (m & 2047)] = val / sum;
    }
    __syncthreads();
}
__device__ __forceinline__ void topk_phase(Frame& F) {
    LAS float* as = (LAS float*)(F.lds + RING_OFF); const int tid = opq(F.tid);
    const float* AFFT = (const float*)(F.ws + WS_AFFT); int* IDX = (int*)(F.ws + WS_IDX); float* GATE = (float*)(F.ws + WS_GATE); int* SLOTOF = (int*)(F.ws + WS_SLOTOF);
    for (int u = blockIdx.x; u < BATCH * NE; u += F.G) {
        const int b = u >> 4, e = u & 15; const float* a = AFFT + (size_t)u * SEQ;
        float ai[4];
#pragma unroll
        for (int ii = 0; ii < 4; ++ii) { ai[ii] = a[tid + 512 * ii]; as[tid + 512 * ii] = ai[ii]; }
        __syncthreads();
        int cnt[4] = {0, 0, 0, 0};
        for (int j4 = 0; j4 < SEQ / 4; ++j4) { const f32x4 aj = *(const LAS f32x4*)(as + 4 * j4);
#pragma unroll
            for (int q = 0; q < 4; ++q) { const float v = aj[q]; const int j = 4 * j4 + q;
#pragma unroll
                for (int ii = 0; ii < 4; ++ii) { const int i = tid + 512 * ii; cnt[ii] += (v > ai[ii] || (v == ai[ii] && j < i)) ? 1 : 0; } } }
#pragma unroll
        for (int ii = 0; ii < 4; ++ii) { const int i = tid + 512 * ii; const int tokrow = b * SEQ + i;
            if (cnt[ii] < CAP) { const int slot = (e * BATCH + b) * CAP + cnt[ii]; IDX[slot] = tokrow; GATE[slot] = ai[ii]; SLOTOF[(size_t)tokrow * 16 + e] = cnt[ii]; }
            else SLOTOF[(size_t)tokrow * 16 + e] = -1; }
        __syncthreads();
    }
}
__device__ __forceinline__ void gather_phase(Frame& F) {
    const int* IDX = (const int*)(F.ws + WS_IDX); const bf16* HN = (const bf16*)(F.ws + WS_HN); bf16* XIN = (bf16*)(F.ws + WS_XIN); const int lane = opq(F.lane);
    for (int s = F.gw; s < NSLOT; s += F.NGW) { const int r = IDX[s];
        const GAS v4u* src = (const GAS v4u*)(HN + (size_t)r * D); GAS v4u* dst = (GAS v4u*)(XIN + (size_t)s * D);
        dst[lane] = src[lane]; dst[lane + 64] = src[lane + 64]; }
}
__device__ __forceinline__ void combine_norm(Frame& F, const float* gnext) {
    const int lane = opq(F.lane); const int* SLOTOF = (const int*)(F.ws + WS_SLOTOF); const bf16* Y = (const bf16*)(F.ws + WS_Y); bf16* HN = (bf16*)(F.ws + WS_HN); float* x = F.out;
    f32x4 gg[4];
#pragma unroll
    for (int j = 0; j < 4; ++j) gg[j] = gnext ? ((const GAS f32x4*)gnext)[lane + 64 * j] : (f32x4){0.f, 0.f, 0.f, 0.f};
    for (int m = F.gw; m < M; m += F.NGW) {
        GAS f32x4* xr = (GAS f32x4*)(x + (size_t)m * D) + lane; f32x4 v[4];
#pragma unroll
        for (int j = 0; j < 4; ++j) v[j] = xr[64 * j];
        const int so = SLOTOF[(size_t)m * 16 + (lane & 15)]; const int b = m >> 11;
#pragma unroll
        for (int e = 0; e < 16; ++e) { const int se = __shfl(so, e);
            if (se >= 0) { const GAS unsigned long long* yr = (const GAS unsigned long long*)(Y + ((size_t)((e * BATCH + b) * CAP + se)) * D) + lane;
#pragma unroll
                for (int j = 0; j < 4; ++j) { const unsigned long long w = yr[64 * j]; const unsigned lo = (unsigned)w, hi = (unsigned)(w >> 32);
                    v[j].x += bflo(lo); v[j].y += bfhi(lo); v[j].z += bflo(hi); v[j].w += bfhi(hi); } } }
#pragma unroll
        for (int j = 0; j < 4; ++j) xr[64 * j] = v[j];
        if (gnext) { rms_apply(v, gg); store_row_bf16(HN + (size_t)m * D, lane, v); }
    }
}

constexpr int PPL = 11;
constexpr int NPHASE = 1 + NLAYER * PPL;
template <int L> __device__ __forceinline__ void layer_body(Frame& F, const Args& args, const XcdBarrier& bar, const int lo, const int hi) {
#define IN(k) (lo <= (k) && (k) < hi)
#define SEAM(k) do { if (IN(k) && IN((k) + 1)) xcd_barrier(bar); } while (0)
    unsigned char* ws = args.ws;
    bf16* HN = (bf16*)(ws + WS_HN); bf16* QKV = (bf16*)(ws + WS_QKV); bf16* OB = (bf16*)(ws + WS_O);

        const int pb = 1 + L * PPL;
        const int nqkv = (L == 3) ? 9216 : 3072;
        if (IN(pb + 0)) {
            pg8::Gemm g{HN, (const bf16*)(ws + wqkv_off(L)), M, nqkv, D}; pg8::StaticOrder S; S.init(M, nqkv, F.G, (int)blockIdx.x);
            pg8::EpiStore E{QKV, nqkv, nqkv / 256};
            pg8::gemm_phase<pg8::EpiStore, pg8::StaticOrder, true, true>(F.lds + RING_OFF, g, S, E);
        } SEAM(pb + 0);
        if (IN(pb + 1)) {
            if constexpr (L == 0) prep_phase(F, QKV, 3072, 1, args.in[I_NA_QN], args.in[I_NA_KN], false);
            else if constexpr (L == 1) prep_phase(F, QKV, 3072, 1, args.in[I_DF_QN], args.in[I_DF_KN], true);
            else if constexpr (L == 3) prep_phase(F, QKV, 9216, 3, args.in[I_DL_QN], args.in[I_DL_KN], true);
        } SEAM(pb + 1);
        if (IN(pb + 2)) {
            if constexpr (L == 0) na_naive(F, QKV, args.in[I_NA_RPB], OB);
            else if constexpr (L == 1) diff_naive_a(F, QKV, (float*)(ws + WS_OG));
            else if constexpr (L == 2) conv_naive(F, QKV, args.in[I_SC_CONV], OB);
            else dil_naive(F, QKV, (bf16*)(ws + WS_OG), (float*)(ws + WS_LSE));
        } SEAM(pb + 2);
        if (IN(pb + 3)) {
            if constexpr (L == 1) diff_naive_b(F, args, (const float*)(ws + WS_OG), OB, 0.8f - 0.6f * 0.7408182206817179f);
            else if constexpr (L == 3) dil_merge(F, (const bf16*)(ws + WS_OG), (const float*)(ws + WS_LSE), OB);
        } SEAM(pb + 3);
        if (IN(pb + 4)) {
            pg8::Gemm g{OB, (const bf16*)(ws + WS_WOUT + (size_t)L * 2 * MiB), M, D, D}; pg8::StaticOrder S; S.init(M, D, F.G, (int)blockIdx.x);
            pg8::EpiResid E{L == 0 ? args.in[I_X] : F.out, F.out, D};
            pg8::gemm_phase<pg8::EpiResid, pg8::StaticOrder, true, true>(F.lds + RING_OFF, g, S, E);
        } SEAM(pb + 4);
        if (IN(pb + 5)) { norm2_router(F, args, L); } SEAM(pb + 5);
        if (IN(pb + 6)) { topk_phase(F); } SEAM(pb + 6);
        if (IN(pb + 7)) { gather_phase(F); } SEAM(pb + 7);
        if (IN(pb + 8)) {
            pg8::Gemm g{(const bf16*)(ws + WS_XIN), (const bf16*)(ws + WS_WGU + (size_t)L * 128 * MiB), NSLOT, 2 * DFF, D}; pg8::MoeOrder S; S.init(NE, 16, 16, F.G, F.vcu);
            pg8::EpiSwiglu E{(bf16*)(ws + WS_HMID), DFF, 16};
            pg8::gemm_phase<pg8::EpiSwiglu, pg8::MoeOrder, true, true>(F.lds + RING_OFF, g, S, E);
        } SEAM(pb + 8);
        if (IN(pb + 9)) {
            pg8::Gemm g{(const bf16*)(ws + WS_HMID), (const bf16*)(ws + WS_WDN + (size_t)L * 64 * MiB), NSLOT, D, DFF}; pg8::MoeOrder S; S.init(NE, 16, 4, F.G, F.vcu);
            pg8::EpiGate E{(bf16*)(ws + WS_Y), D, 4, (const float*)(ws + WS_GATE)};
            pg8::gemm_phase<pg8::EpiGate, pg8::MoeOrder, true, true>(F.lds + RING_OFF, g, S, E);
        } SEAM(pb + 9);
        if (IN(pb + 10)) { combine_norm(F, L + 1 < NLAYER ? args.in[I_GMIX] + (size_t)(L + 1) * D : nullptr); } SEAM(pb + 10);
    #undef IN
#undef SEAM
}
__global__ void __launch_bounds__(NWAVES * 64, 2) fwd_kernel(Args args) {
    extern __shared__ __attribute__((aligned(16))) unsigned char lds[];
    Frame F;
    F.lds = (LAS unsigned char*)lds;
    F.MISC = (volatile LAS unsigned*)(F.lds + MISC_OFF);
    F.tid = threadIdx.x; F.lane = F.tid & 63; F.wave = __builtin_amdgcn_readfirstlane(F.tid >> 6);
    F.G = gridDim.x; { const int bx = blockIdx.x; F.vcu = (F.G % 8 == 0) ? (bx % 8) * (F.G / 8) + bx / 8 : bx; }
    F.gw = F.vcu * NWAVES + F.wave; F.NGW = F.G * NWAVES;
    F.out = args.out; F.ws = args.ws;
    F.ctl = (gu32*)(args.ws + WS_CTL);
    for (int u = F.tid; u < (LDS_BYTES - LDSCTL_OFF) / 4; u += NWAVES * 64) ((LAS unsigned*)(F.lds + LDSCTL_OFF))[u] = 0u;
    __syncthreads();
    const int lo = args.ph_lo, hi = args.ph_hi;
    XcdBarrier bar; bar.bar = (unsigned*)(F.ctl + CW_BAR) + args.li * XCD_BAR_WORDS; bar.x = 0; bar.st = nullptr;
    if (hi - lo > 1) bar = xcd_barrier_post((unsigned*)(F.ctl + CW_BAR) + args.li * XCD_BAR_WORDS, F.MISC + 8);
#define IN(k) (lo <= (k) && (k) < hi)
#define SEAM(k) do { if (IN(k) && IN((k) + 1)) xcd_barrier(bar); } while (0)
    unsigned char* ws = args.ws;
    bf16* HN = (bf16*)(ws + WS_HN); bf16* QKV = (bf16*)(ws + WS_QKV); bf16* OB = (bf16*)(ws + WS_O);

    if (IN(0)) { p0_prologue(F, args); } SEAM(0);

    layer_body<0>(F, args, bar, lo, hi); layer_body<1>(F, args, bar, lo, hi); layer_body<2>(F, args, bar, lo, hi); layer_body<3>(F, args, bar, lo, hi);
#undef IN
#undef SEAM
}

#ifndef MK_N_LAUNCHES
#define MK_N_LAUNCHES 1
#endif
extern "C" void kernel_launch(void* const* d_in, const int* in_sizes, int n_in, void* d_out, int out_size, void* d_ws, size_t ws_size, hipStream_t stream) {
    static int grid = 0;
    if (grid == 0) {
        if (n_in != N_IN || in_sizes[0] != M * D || out_size != M * D || ws_size < WS_END) { fprintf(stderr, "kernel_launch: unexpected shapes: n_in %d in0 %d out %d ws %zu (need %zu)\n", n_in, n_in > 0 ? in_sizes[0] : -1, out_size, ws_size, (size_t)WS_END); grid = -1; return; }
        int dev = 0, cus = 0, per_cu = 0;
        if (hipGetDevice(&dev) != hipSuccess || hipDeviceGetAttribute(&cus, hipDeviceAttributeMultiprocessorCount, dev) != hipSuccess) { grid = -1; return; }
        if (hipFuncSetAttribute((const void*)fwd_kernel, hipFuncAttributeMaxDynamicSharedMemorySize, LDS_BYTES) != hipSuccess) { fprintf(stderr, "kernel_launch: hipFuncSetAttribute failed\n"); grid = -1; return; }
        if (hipOccupancyMaxActiveBlocksPerMultiprocessor(&per_cu, (const void*)fwd_kernel, NWAVES * 64, LDS_BYTES) != hipSuccess || per_cu < 1) fprintf(stderr, "kernel_launch: occupancy query reports %d\n", per_cu);
        (void)hipGetLastError();
        grid = cus;
    }
    if (grid < 0) return;
    if (hipMemsetAsync((char*)d_ws + WS_CTL, 0, CTL_ZERO_BYTES, stream) != hipSuccess) return;
    Args a{};
    for (int i = 0; i < N_IN; ++i) a.in[i] = (const float*)d_in[i];
    a.out = (float*)d_out; a.ws = (unsigned char*)d_ws; a.pad = 0;
    if (MK_N_LAUNCHES == 1) {
        a.ph_lo = 0; a.ph_hi = NPHASE; a.li = 0;
        hipLaunchKernelGGL(fwd_kernel, dim3(grid), dim3(NWAVES * 64), LDS_BYTES, stream, a);
    } else {
        for (int p = 0; p < NPHASE; ++p) { a.ph_lo = p; a.ph_hi = p + 1; a.li = 0;
            hipLaunchKernelGGL(fwd_kernel, dim3(grid), dim3(NWAVES * 64), LDS_BYTES, stream, a); }
    }
    const hipError_t le = hipPeekAtLastError();
    if (le != hipSuccess) fprintf(stderr, "kernel_launch: launch failed: %s\n", hipGetErrorName(le));
}
```

```cpp
#include <hip/hip_runtime.h>
#include <cstdio>
#include <cstdint>
namespace pg8 {
#define PG8_LAS __attribute__((address_space(3)))
typedef unsigned short bf16_t;
typedef short bf16x8 __attribute__((ext_vector_type(8)));
typedef float f32x4 __attribute__((ext_vector_type(4)));
typedef unsigned u32x4 __attribute__((ext_vector_type(4)));
constexpr int BM = 256, BK = 64, HALF = 128, HTB = HALF * BK * 2  , STAGE_BYTES = 8 * HTB, NXCD = 8, WGM = 4;

__host__ __device__ __forceinline__ int lds_byte(int r, int c) { const int st = (r >> 4) * 2 + (c >> 5), rr = r & 15, cc = c & 31, ob = rr * 64 + cc * 2; return st * 1024 + (ob ^ (((ob >> 9) & 1) << 5)); }
__host__ __device__ __forceinline__ void stage_rc(int b, int& R, int& C) { const int st = b / 1024, sb = b % 1024, swz = sb ^ (((sb >> 9) & 1) << 5); R = (st >> 1) * 16 + swz / 64; C = (st & 1) * 32 + (swz % 64) / 2; }
__host__ __device__ __forceinline__ int perm32(int rho) { const int n = rho >> 4, i = rho & 15; return 8 * (i >> 2) + 4 * n + (i & 3); }

struct Unit { int pm, pn; };
struct Gemm { const bf16_t* A; const bf16_t* Bt; int M, N, K; };

struct StaticOrder {
    int nM, nN, nwg, G, c;
    __host__ __device__ void init(int M, int N, int G_, int c_) { nM = M / BM; nN = N / BM; nwg = nM * nN; G = G_; c = c_; }
    __host__ __device__ bool next(int i, Unit& u) const {
        const long L = (long)i * G + c; if (L >= nwg) return false;
        int wgid = (int)L; { const int q = nwg / NXCD, r = nwg % NXCD, xcd = wgid % NXCD, off = wgid / NXCD; wgid = (xcd < r ? xcd * (q + 1) : r * (q + 1) + (xcd - r) * q) + off; }
        const int nig = WGM * nN, gid = wgid / nig, fm = gid * WGM, gsz = (nM - fm) < WGM ? (nM - fm) : WGM;
        u.pm = fm + ((wgid % nig) % gsz); u.pn = (wgid % nig) / gsz; return true;
    }
    __device__ __forceinline__ void a_ready(const Unit&) const {}
    __device__ __forceinline__ void done(const Unit&) const {}
};

__device__ __forceinline__ unsigned cvt_pk_bf16(float lo, float hi) { unsigned r; asm volatile("v_cvt_pk_bf16_f32 %0, %1, %2" : "=v"(r) : "v"(lo), "v"(hi)); return r; }
typedef float f32x2 __attribute__((ext_vector_type(2)));
__device__ __forceinline__ f32x2 gelu_pk(f32x2 v) {
    const f32x2 av = __builtin_elementwise_abs(v), d = av * 0.2316418882f + 1.0f;
    f32x2 t; t.x = __builtin_amdgcn_rcpf(d.x); t.y = __builtin_amdgcn_rcpf(d.y);
    f32x2 q = t * 0.5307027145f + (-0.7265760135f); q = q * t + 0.7107068705f; q = q * t + (-0.142248368f); q = q * t + 0.127414796f; q = q * t;
    const f32x2 s = (v * v) * (-0.72134752044f);
    f32x2 e; e.x = __builtin_amdgcn_exp2f(s.x); e.y = __builtin_amdgcn_exp2f(s.y);
    const f32x2 m = v * (q * e), r = v - m;
    f32x2 o; o.x = v.x < 0.f ? m.x : r.x; o.y = v.y < 0.f ? m.y : r.y; return o;
}

template <int ACT  > struct EpiBf16 {
    static constexpr bool PERM = true, AFTER_DRAIN = false; static_assert(ACT == 0 || ACT == 1, "EpiBf16: ACT is 0 (none) or 1 (gelu_pk)");
    bf16_t* O; int ldc; const float* bias; int split_cols; size_t split_stride; float scale0;
    __device__ __forceinline__ void operator()(const f32x4 (&acc)[2][2][4][2], const Unit& u, int wr, int wc, int fr, int fq) const {
        const int row0 = u.pm * BM + wr * 64 + fr; int colt = u.pn * BM; bf16_t* base = O;
        float sc = 1.f; if (split_cols) { const int t = colt / split_cols; base += (size_t)t * split_stride; colt -= t * split_cols; if (t == 0) sc = scale0; }
        const int col0 = colt + wc * 32 + 8 * fq, bcol0 = u.pn * BM + wc * 32 + 8 * fq;
        f32x4 bv[2][2];
#pragma unroll
        for (int bj = 0; bj < 2; ++bj)
#pragma unroll
            for (int n = 0; n < 2; ++n) bv[bj][n] = bias ? *(const f32x4*)(bias + bcol0 + bj * HALF + 4 * n) : (f32x4){0.f, 0.f, 0.f, 0.f};
#pragma unroll
        for (int ai = 0; ai < 2; ++ai)
#pragma unroll
            for (int m = 0; m < 4; ++m) { bf16_t* rowp = base + (size_t)(row0 + ai * HALF + m * 16) * ldc + col0;
#pragma unroll
                for (int bj = 0; bj < 2; ++bj) { f32x4 v0 = acc[ai][bj][m][0] + bv[bj][0], v1 = acc[ai][bj][m][1] + bv[bj][1];
                    if (ACT == 1) { f32x2 a = gelu_pk((f32x2){v0[0], v0[1]}), b = gelu_pk((f32x2){v0[2], v0[3]}), c = gelu_pk((f32x2){v1[0], v1[1]}), d = gelu_pk((f32x2){v1[2], v1[3]});
                        v0 = (f32x4){a.x, a.y, b.x, b.y}; v1 = (f32x4){c.x, c.y, d.x, d.y}; }
                    v0 = v0 * sc; v1 = v1 * sc; u32x4 w; w.x = cvt_pk_bf16(v0[0], v0[1]); w.y = cvt_pk_bf16(v0[2], v0[3]); w.z = cvt_pk_bf16(v1[0], v1[1]); w.w = cvt_pk_bf16(v1[2], v1[3]);
                    *(u32x4*)(rowp + bj * HALF) = w; } }
    }
};
struct EpiStore {
    static constexpr bool PERM = true, AFTER_DRAIN = false;
    bf16_t* O; int ldc; int ntn; float sc;
    __device__ __forceinline__ void operator()(const f32x4 (&acc)[2][2][4][2], const Unit& u, int wr, int wc, int fr, int fq) const {
        const int row0 = u.pm * BM + wr * 64 + fr; const int col0 = (u.pn % ntn) * BM + wc * 32 + 8 * fq;
#pragma unroll
        for (int ai = 0; ai < 2; ++ai)
#pragma unroll
            for (int m = 0; m < 4; ++m) { bf16_t* rowp = O + (size_t)(row0 + ai * HALF + m * 16) * ldc + col0;
#pragma unroll
                for (int bj = 0; bj < 2; ++bj) { const f32x4 v0 = acc[ai][bj][m][0] * sc, v1 = acc[ai][bj][m][1] * sc;
                    u32x4 w; w.x = cvt_pk_bf16(v0[0], v0[1]); w.y = cvt_pk_bf16(v0[2], v0[3]); w.z = cvt_pk_bf16(v1[0], v1[1]); w.w = cvt_pk_bf16(v1[2], v1[3]);
                    *(u32x4*)(rowp + bj * HALF) = w; } }
    }
};
template <bool XF32> struct EpiResidB {
    static constexpr bool PERM = true, AFTER_DRAIN = false;
    const void* X; bf16_t* O; int ldc; float sc;
    __device__ __forceinline__ void operator()(const f32x4 (&acc)[2][2][4][2], const Unit& u, int wr, int wc, int fr, int fq) const {
        const int row0 = u.pm * BM + wr * 64 + fr; const int col0 = u.pn * BM + wc * 32 + 8 * fq;
#pragma unroll
        for (int ai = 0; ai < 2; ++ai)
#pragma unroll
            for (int mh = 0; mh < 2; ++mh) {
                f32x4 xa[2][2][2];
#pragma unroll
                for (int mm = 0; mm < 2; ++mm)
#pragma unroll
                    for (int bj = 0; bj < 2; ++bj) { const size_t off = (size_t)(row0 + ai * HALF + (2 * mh + mm) * 16) * ldc + col0 + bj * HALF;
                        if constexpr (XF32) { xa[mm][bj][0] = *(const f32x4*)((const float*)X + off); xa[mm][bj][1] = *(const f32x4*)((const float*)X + off + 4); }
                        else { const u32x4 w = *(const u32x4*)((const bf16_t*)X + off);
                            xa[mm][bj][0] = (f32x4){__uint_as_float(w.x << 16), __uint_as_float(w.x & 0xffff0000u), __uint_as_float(w.y << 16), __uint_as_float(w.y & 0xffff0000u)};
                            xa[mm][bj][1] = (f32x4){__uint_as_float(w.z << 16), __uint_as_float(w.z & 0xffff0000u), __uint_as_float(w.w << 16), __uint_as_float(w.w & 0xffff0000u)}; } }
#pragma unroll
                for (int mm = 0; mm < 2; ++mm)
#pragma unroll
                    for (int bj = 0; bj < 2; ++bj) { const int m = 2 * mh + mm; const size_t off = (size_t)(row0 + ai * HALF + m * 16) * ldc + col0 + bj * HALF;
                        const f32x4 v0 = acc[ai][bj][m][0] * sc + xa[mm][bj][0], v1 = acc[ai][bj][m][1] * sc + xa[mm][bj][1];
                        u32x4 w; w.x = cvt_pk_bf16(v0[0], v0[1]); w.y = cvt_pk_bf16(v0[2], v0[3]); w.z = cvt_pk_bf16(v1[0], v1[1]); w.w = cvt_pk_bf16(v1[2], v1[3]);
                        *(u32x4*)(O + off) = w; } }
    }
};
__device__ __forceinline__ unsigned pk4_fp8(float a, float b, float c, float d) {
    a = __builtin_amdgcn_fmed3f(a, -448.f, 448.f); b = __builtin_amdgcn_fmed3f(b, -448.f, 448.f); c = __builtin_amdgcn_fmed3f(c, -448.f, 448.f); d = __builtin_amdgcn_fmed3f(d, -448.f, 448.f);
    int w = 0; w = __builtin_amdgcn_cvt_pk_fp8_f32(a, b, w, false); w = __builtin_amdgcn_cvt_pk_fp8_f32(c, d, w, true); return (unsigned)w; }
struct EpiQKV {
    static constexpr bool PERM = true, AFTER_DRAIN = false;
    bf16_t* O; int ldc; const float* qg; const float* kg; const float* rope; float qscale; int plain; float eps; float asc;
    int layout;
    __device__ __forceinline__ bf16_t* rowptr(int row, int pn, int wc, int fq) const {
        if (layout == 0) return O + (size_t)row * ldc + pn * BM + 64 * wc + 8 * fq;
        const int g = pn / 12, t = (pn % 12) >> 2, c64 = ((pn & 3) << 2) + wc, b = row >> 11; int pos = row & 2047;
        if (layout == 3) { const int dsh = 2 * g; pos = ((pos & ((1 << dsh) - 1)) << (11 - dsh)) + (pos >> dsh); }
        bf16_t* base = O + (size_t)(3 * g + t) * (32u << 20);
        if (layout == 2 && t == 2) return base + ((size_t)((b * 8 + (c64 >> 1)) * 2048 + pos)) * 128 + (c64 & 1) * 64 + 8 * fq;
        return base + ((size_t)((b * 16 + c64) * 2048 + pos)) * 64 + 8 * fq;
    }
    __device__ __forceinline__ void operator()(const f32x4 (&acc)[2][2][4][2], const Unit& u, int wr, int wc, int fr, int fq) const {
        const int t12 = u.pn % 12, mode = plain ? 2 : (t12 < 4 ? 0 : (t12 < 8 ? 1 : 2));
        const int row0 = u.pm * BM + wr * 64 + fr;
        if (mode == 2) {
#pragma unroll
            for (int ai = 0; ai < 2; ++ai)
#pragma unroll
                for (int m = 0; m < 4; ++m) { bf16_t* rowp = rowptr(row0 + ai * HALF + m * 16, u.pn, wc, fq);
#pragma unroll
                    for (int bj = 0; bj < 2; ++bj) { const f32x4 v0 = acc[ai][bj][m][0] * asc, v1 = acc[ai][bj][m][1] * asc;
                        u32x4 w; w.x = cvt_pk_bf16(v0[0], v0[1]); w.y = cvt_pk_bf16(v0[2], v0[3]); w.z = cvt_pk_bf16(v1[0], v1[1]); w.w = cvt_pk_bf16(v1[2], v1[3]);
                        if (layout == 3) { typedef unsigned u32x2q __attribute__((ext_vector_type(2))); u32x2q w8; w8.x = pk4_fp8(v0[0] * 16.f, v0[1] * 16.f, v0[2] * 16.f, v0[3] * 16.f); w8.y = pk4_fp8(v1[0] * 16.f, v1[1] * 16.f, v1[2] * 16.f, v1[3] * 16.f);
                            *(u32x2q*)((unsigned char*)O + (rowp - O) + bj * 32) = w8; }
                        else *(u32x4*)(rowp + bj * 32) = w; } }
        } else {
            const float* gs = mode ? kg : qg; const float sc = mode ? 1.0f : qscale;
            float g0[8], g1[8];
#pragma unroll
            for (int i = 0; i < 8; ++i) { g0[i] = gs[8 * fq + i] * sc; g1[i] = gs[32 + 8 * fq + i] * sc; }
#pragma unroll
            for (int ai = 0; ai < 2; ++ai)
#pragma unroll
                for (int m = 0; m < 4; ++m) { const int row = row0 + ai * HALF + m * 16; bf16_t* rowp = rowptr(row, u.pn, wc, fq);
                    float y0[8], y1[8];
#pragma unroll
                    for (int i = 0; i < 4; ++i) { y0[i] = acc[ai][0][m][0][i] * asc; y0[4 + i] = acc[ai][0][m][1][i] * asc; y1[i] = acc[ai][1][m][0][i] * asc; y1[4 + i] = acc[ai][1][m][1][i] * asc; }
                    float ss = 0.f;
#pragma unroll
                    for (int i = 0; i < 8; ++i) ss += y0[i] * y0[i] + y1[i] * y1[i];
                    ss += __shfl_xor(ss, 16); ss += __shfl_xor(ss, 32);
                    const float rstd = __builtin_amdgcn_rsqf(ss * (1.f / 64.f) + eps);
#pragma unroll
                    for (int i = 0; i < 8; ++i) { y0[i] *= rstd * g0[i]; y1[i] *= rstd * g1[i]; }
                    if (rope) { const f32x4* rp = (const f32x4*)(rope + ((size_t)(row & 2047) * 32 + 8 * fq) * 2);
#pragma unroll
                        for (int i2 = 0; i2 < 4; ++i2) { const f32x4 cs = rp[i2];
                            const float a0 = y0[2 * i2], b0 = y1[2 * i2], a1 = y0[2 * i2 + 1], b1 = y1[2 * i2 + 1];
                            y0[2 * i2] = a0 * cs[0] - b0 * cs[1]; y1[2 * i2] = b0 * cs[0] + a0 * cs[1];
                            y0[2 * i2 + 1] = a1 * cs[2] - b1 * cs[3]; y1[2 * i2 + 1] = b1 * cs[2] + a1 * cs[3]; } }
                    u32x4 w0, w1;
                    w0.x = cvt_pk_bf16(y0[0], y0[1]); w0.y = cvt_pk_bf16(y0[2], y0[3]); w0.z = cvt_pk_bf16(y0[4], y0[5]); w0.w = cvt_pk_bf16(y0[6], y0[7]);
                    w1.x = cvt_pk_bf16(y1[0], y1[1]); w1.y = cvt_pk_bf16(y1[2], y1[3]); w1.z = cvt_pk_bf16(y1[4], y1[5]); w1.w = cvt_pk_bf16(y1[6], y1[7]);
                    if (layout == 3) { typedef unsigned u32x2q __attribute__((ext_vector_type(2))); u32x2q a8, b8; unsigned char* r8 = (unsigned char*)O + (rowp - O);
                        a8.x = pk4_fp8(y0[0] * 16.f, y0[1] * 16.f, y0[2] * 16.f, y0[3] * 16.f); a8.y = pk4_fp8(y0[4] * 16.f, y0[5] * 16.f, y0[6] * 16.f, y0[7] * 16.f);
                        b8.x = pk4_fp8(y1[0] * 16.f, y1[1] * 16.f, y1[2] * 16.f, y1[3] * 16.f); b8.y = pk4_fp8(y1[4] * 16.f, y1[5] * 16.f, y1[6] * 16.f, y1[7] * 16.f);
                        *(u32x2q*)r8 = a8; *(u32x2q*)(r8 + 32) = b8; }
                    else { *(u32x4*)rowp = w0; *(u32x4*)(rowp + 32) = w1; } }
        }
    }
};
struct EpiResid {
    static constexpr bool PERM = false, AFTER_DRAIN = false;
    const float* base; float* out; int ldc;
    __device__ __forceinline__ void operator()(const f32x4 (&acc)[2][2][4][2], const Unit& u, int wr, int wc, int fr, int fq) const {
        const int row0 = u.pm * BM + wr * 64 + fr; const int col0 = u.pn * BM + wc * 32 + 4 * fq;
#pragma unroll
        for (int ai = 0; ai < 2; ++ai)
#pragma unroll
            for (int m = 0; m < 4; ++m) { const size_t off = (size_t)(row0 + ai * HALF + m * 16) * ldc + col0;
#pragma unroll
                for (int bj = 0; bj < 2; ++bj)
#pragma unroll
                    for (int n = 0; n < 2; ++n) { const f32x4 b = *(const f32x4*)(base + off + bj * HALF + n * 16); *(f32x4*)(out + off + bj * HALF + n * 16) = b + acc[ai][bj][m][n]; } }
    }
};
struct EpiSwiglu {
    static constexpr bool PERM = true, AFTER_DRAIN = false;
    bf16_t* O; int ldc; int ntn;
    __device__ __forceinline__ void operator()(const f32x4 (&acc)[2][2][4][2], const Unit& u, int wr, int wc, int fr, int fq) const {
        typedef unsigned u32x2v __attribute__((ext_vector_type(2)));
        const int row0 = u.pm * BM + wr * 64 + fr; const int col0 = (u.pn % ntn) * HALF + wc * 16 + 4 * fq;
#pragma unroll
        for (int ai = 0; ai < 2; ++ai)
#pragma unroll
            for (int m = 0; m < 4; ++m) { bf16_t* rowp = O + (size_t)(row0 + ai * HALF + m * 16) * ldc + col0;
#pragma unroll
                for (int bj = 0; bj < 2; ++bj) { const f32x4 g = acc[ai][bj][m][0], uu = acc[ai][bj][m][1]; float h[4];
#pragma unroll
                    for (int e = 0; e < 4; ++e) h[e] = g[e] * __builtin_amdgcn_rcpf(1.0f + __expf(-g[e])) * uu[e];
                    u32x2v w; w.x = cvt_pk_bf16(h[0], h[1]); w.y = cvt_pk_bf16(h[2], h[3]);
                    *(u32x2v*)(rowp + bj * 64) = w; } }
    }
};
struct EpiSwiglu8 {
    static constexpr bool PERM = true, AFTER_DRAIN = false;
    unsigned char* O; int ldc; int ntn; float sin, sout;
    __device__ __forceinline__ void operator()(const f32x4 (&acc)[2][2][4][2], const Unit& u, int wr, int wc, int fr, int fq) const {
        typedef unsigned u32x2v __attribute__((ext_vector_type(2)));
        const int row0 = u.pm * BM + wr * 64 + fr; const int col0 = (u.pn % ntn) * HALF + wc * 32 + 8 * fq;
        const float c1 = -sin * 1.4426950408889634f, c2 = sin * sin * sout;
#pragma unroll
        for (int ai = 0; ai < 2; ++ai)
#pragma unroll
            for (int m = 0; m < 4; ++m) { unsigned char* rowp = O + (size_t)(row0 + ai * HALF + m * 16) * ldc + col0; u32x2v w;
#pragma unroll
                for (int n = 0; n < 2; ++n) { const f32x4 g = acc[ai][0][m][n], uu = acc[ai][1][m][n]; f32x2 h[2];
#pragma unroll
                    for (int p = 0; p < 2; ++p) { const f32x2 a = (f32x2){g[2 * p], g[2 * p + 1]}, b = (f32x2){uu[2 * p], uu[2 * p + 1]};
                        const f32x2 t = a * c1; f32x2 e_; e_.x = __builtin_amdgcn_exp2f(t.x); e_.y = __builtin_amdgcn_exp2f(t.y);
                        const f32x2 d = e_ + 1.0f; f32x2 r; r.x = __builtin_amdgcn_rcpf(d.x); r.y = __builtin_amdgcn_rcpf(d.y);
                        h[p] = ((a * c2) * b) * r; }
                    w[n] = pk4_fp8(h[0].x, h[0].y, h[1].x, h[1].y); }
                *(u32x2v*)rowp = w; }
    }
};
struct EpiGate {
    static constexpr bool PERM = true, AFTER_DRAIN = false;
    unsigned char* O; int ldc; int ntn; const float* gate; float sc;
    __device__ __forceinline__ void operator()(const f32x4 (&acc)[2][2][4][2], const Unit& u, int wr, int wc, int fr, int fq) const {
        typedef unsigned u32x2v __attribute__((ext_vector_type(2)));
        const int row0 = u.pm * BM + wr * 64 + fr; const int col0 = (u.pn % ntn) * BM + wc * 32 + 8 * fq;
#pragma unroll
        for (int ai = 0; ai < 2; ++ai)
#pragma unroll
            for (int m = 0; m < 4; ++m) { const int row = row0 + ai * HALF + m * 16; const float gs = gate[row] * sc; unsigned char* rowp = O + (size_t)row * ldc + col0;
#pragma unroll
                for (int bj = 0; bj < 2; ++bj) { const f32x4 v0 = acc[ai][bj][m][0] * gs, v1 = acc[ai][bj][m][1] * gs;
                    u32x2v w; w.x = pk4_fp8(v0[0], v0[1], v0[2], v0[3]); w.y = pk4_fp8(v1[0], v1[1], v1[2], v1[3]);
                    *(u32x2v*)(rowp + bj * HALF) = w; } }
    }
};
struct MoeOrder {
    int nN, mpe, total, G, v, blk4x8;
    __device__ void init(int nE, int mpe_, int nN_, int G_, int v_, int blk = 0) { nN = nN_; mpe = mpe_; total = nE * mpe_ * nN_; G = G_; v = v_; blk4x8 = blk && (mpe_ == 16) && (nN_ == 16) && (G_ == 256); }
    __device__ bool next(int i, Unit& u) const {
        const long L = (long)i * G + v; if (L >= total) return false;
        const int per = mpe * nN, e = (int)L / per, r = (int)L % per;
        if (blk4x8) { const int x = r >> 5, j = r & 31;
            u.pm = e * mpe + 4 * (x >> 1) + (j >> 3); u.pn = e * nN + 8 * (x & 1) + (j & 7); return true; }
        u.pm = e * mpe + r / nN; u.pn = e * nN + r % nN; return true;
    }
    __device__ __forceinline__ void a_ready(const Unit&) const {}
    __device__ __forceinline__ void done(const Unit&) const {}
};
typedef int i32x4_t __attribute__((ext_vector_type(4))); typedef int i32x8_t __attribute__((ext_vector_type(8)));
template <bool FP8> struct FragSel;
template <> struct FragSel<false> { struct T { bf16x8 k[2]; };
    static __device__ __forceinline__ void load(T& d, const PG8_LAS unsigned char* p) { d.k[0] = *(const PG8_LAS bf16x8*)p; d.k[1] = *(const PG8_LAS bf16x8*)(p + 1024); }
    static __device__ __forceinline__ void mma(f32x4& c, const T& w, const T& a) { c = __builtin_amdgcn_mfma_f32_16x16x32_bf16(w.k[0], a.k[0], c, 0, 0, 0); c = __builtin_amdgcn_mfma_f32_16x16x32_bf16(w.k[1], a.k[1], c, 0, 0, 0); } };
template <> struct FragSel<true> { typedef i32x8_t T;
    static __device__ __forceinline__ void load(T& d, const PG8_LAS unsigned char* p) { const i32x4_t lo = *(const PG8_LAS i32x4_t*)p, hi = *(const PG8_LAS i32x4_t*)(p + 1024); d = __builtin_shufflevector(lo, hi, 0, 1, 2, 3, 4, 5, 6, 7); }
    static __device__ __forceinline__ void mma(f32x4& c, const T& w, const T& a) { asm volatile("v_mfma_f32_16x16x128_f8f6f4 %0, %1, %2, %0" : "+v"(c) : "v"(w), "v"(a)); } };
template <class Epi, class Sched, bool ALIGN_EPI = false, bool SP2 = false, bool FP8 = false>
__device__ __forceinline__ void gemm_phase(PG8_LAS unsigned char* lds, const Gemm g, const Sched& S, const Epi& E, int tid_in) {
    int tid_ = tid_in; asm volatile("" : "+v"(tid_));
    const int tid = tid_, wid = __builtin_amdgcn_readfirstlane(tid >> 6), lane = tid & 63, wr = wid >> 2, wc = wid & 3, fr = lane & 15, fq = lane >> 4;
    const int K = g.K, nt = K / BK;
    unsigned voffA[2], voffB[2];
#pragma unroll
    for (int i = 0; i < 2; ++i) { int R, C; stage_rc(tid * 16 + i * 8192, R, C); const int Rb = Epi::PERM ? ((R & ~31) + perm32(R & 31)) : R;
        voffA[i] = (unsigned)(R * K + C) * 2u; voffB[i] = (unsigned)(Rb * K + C) * 2u; }
    const size_t kstep = (size_t)(BK * 2);
    const size_t hstep = (size_t)HALF * K * 2;
    const size_t tstep = 2 * hstep;
    const unsigned ldsw = (unsigned)wid * 1024u;
    const int aoff = lds_byte(wr * 64 + fr, fq * 8), boff = lds_byte(wc * 32 + fr, fq * 8);
#define PG8_SA(b, h) (((b) * 2 + (h)) * HTB)
#define PG8_SB(b, h) ((4 + (b) * 2 + (h)) * HTB)
#define PG8_STAGE(bufoff, gbase, voff) do { _Pragma("unroll") for (int _i = 0; _i < 2; ++_i) \
        __builtin_amdgcn_global_load_lds((const unsigned*)((const char*)(gbase) + (voff)[_i]), (PG8_LAS unsigned*)(lds + (bufoff) + ldsw + _i * 8192), 16, 0, 0); } while (0)
#define PG8_LDA(dst, b, h) do { _Pragma("unroll") for (int m = 0; m < 4; ++m) FragSel<FP8>::load(dst[m], lds + PG8_SA(b, h) + aoff + m * 2048); } while (0)
#define PG8_LDB(dst, b, h) do { _Pragma("unroll") for (int n = 0; n < 2; ++n) FragSel<FP8>::load(dst[n], lds + PG8_SB(b, h) + boff + n * 2048); } while (0)
#define PG8_MMA(ai, bj, At, Bt) do { __builtin_amdgcn_s_setprio(1); if constexpr (FP8) asm volatile("s_nop 1"); _Pragma("unroll") for (int m = 0; m < 4; ++m) _Pragma("unroll") for (int n = 0; n < 2; ++n) { \
        FragSel<FP8>::mma(acc[ai][bj][m][n], Bt[n], At[m]); } \
        __builtin_amdgcn_s_setprio(0); } while (0)
#define PG8_WAIT_V(n) asm volatile("s_waitcnt vmcnt(" #n ")" ::: "memory")
#define PG8_WAIT_L(n) asm volatile("s_waitcnt lgkmcnt(" #n ")" ::: "memory")
#define PG8_BAR __builtin_amdgcn_s_barrier()
#define PG8_SCHED __builtin_amdgcn_sched_barrier(0)
    Unit cur, nxt; int ui = 0;
    if (!S.next(0, cur)) return;
    f32x4 acc[2][2][4][2];
#pragma unroll
    for (int a = 0; a < 2; ++a)
#pragma unroll
        for (int b = 0; b < 2; ++b)
#pragma unroll
            for (int m = 0; m < 4; ++m)
#pragma unroll
                for (int n = 0; n < 2; ++n) acc[a][b][m][n] = (f32x4){0.f, 0.f, 0.f, 0.f};
    typename FragSel<FP8>::T At[4], B0[2], B1[2];
    const char* cA = (const char*)g.A + (size_t)cur.pm * tstep; const char* cB = (const char*)g.Bt + (size_t)cur.pn * tstep;
    S.a_ready(cur);
    if constexpr (SP2) {
        PG8_STAGE(PG8_SB(0, 0), cB, voffB); PG8_STAGE(PG8_SB(0, 1), cB + hstep, voffB); PG8_STAGE(PG8_SA(0, 0), cA, voffA); PG8_STAGE(PG8_SA(0, 1), cA + hstep, voffA);
        if (wr == 1) PG8_BAR;
        PG8_WAIT_V(2); PG8_BAR;
        PG8_STAGE(PG8_SB(1, 0), cB + kstep, voffB); PG8_STAGE(PG8_SA(1, 0), cA + kstep, voffA); PG8_STAGE(PG8_SB(1, 1), cB + hstep + kstep, voffB);
        PG8_WAIT_V(6); PG8_BAR;
    } else {
        PG8_STAGE(PG8_SB(0, 0), cB, voffB); PG8_STAGE(PG8_SA(0, 0), cA, voffA); PG8_STAGE(PG8_SB(0, 1), cB + hstep, voffB); PG8_STAGE(PG8_SA(0, 1), cA + hstep, voffA);
        if (wr == 1) PG8_BAR;
        PG8_WAIT_V(4); PG8_BAR;
        PG8_STAGE(PG8_SB(1, 0), cB + kstep, voffB); PG8_STAGE(PG8_SA(1, 0), cA + kstep, voffA); PG8_STAGE(PG8_SB(1, 1), cB + hstep + kstep, voffB);
        PG8_WAIT_V(6); PG8_BAR;
    }
    for (;;) {
        const bool has_next = S.next(ui + 1, nxt);
        const char* nA = has_next ? (const char*)g.A + (size_t)nxt.pm * tstep : cA; const char* nB = has_next ? (const char*)g.Bt + (size_t)nxt.pn * tstep : cB;
        for (int t = 0; t < nt; t += 2) {
            const bool last = (t == nt - 2);
            const char* a1 = cA + (size_t)(t + 1) * kstep;
            const char* a2 = last ? nA : cA + (size_t)(t + 2) * kstep; const char* b2 = last ? nB : cB + (size_t)(t + 2) * kstep;
            const char* a3 = a2 + kstep; const char* b3 = b2 + kstep;
            if (last && has_next) S.a_ready(nxt);
            if constexpr (SP2) {
            PG8_LDB(B0, 0, 0); PG8_LDB(B1, 0, 1); PG8_SCHED; PG8_LDA(At, 0, 0); PG8_STAGE(PG8_SA(1, 1), a1 + hstep, voffA);
            PG8_WAIT_V(8); PG8_WAIT_L(0); PG8_BAR; PG8_MMA(0, 0, At, B0); PG8_MMA(0, 1, At, B1); PG8_BAR; PG8_SCHED;
            PG8_LDA(At, 0, 1); PG8_STAGE(PG8_SB(0, 0), b2, voffB); PG8_STAGE(PG8_SB(0, 1), b2 + hstep, voffB); PG8_STAGE(PG8_SA(0, 0), a2, voffA);
            PG8_WAIT_V(8); PG8_WAIT_L(0); PG8_BAR; PG8_MMA(1, 0, At, B0); PG8_MMA(1, 1, At, B1); PG8_BAR; PG8_SCHED;
            PG8_LDB(B0, 1, 0); PG8_LDB(B1, 1, 1); PG8_SCHED; PG8_LDA(At, 1, 0); PG8_STAGE(PG8_SA(0, 1), a2 + hstep, voffA);
            PG8_WAIT_V(8); PG8_WAIT_L(0); PG8_BAR; PG8_MMA(0, 0, At, B0); PG8_MMA(0, 1, At, B1); PG8_BAR; PG8_SCHED;
            PG8_LDA(At, 1, 1); PG8_STAGE(PG8_SB(1, 0), b3, voffB); PG8_STAGE(PG8_SB(1, 1), b3 + hstep, voffB); PG8_STAGE(PG8_SA(1, 0), a3, voffA);
            PG8_WAIT_V(8); PG8_WAIT_L(0); PG8_BAR; PG8_MMA(1, 0, At, B0); PG8_MMA(1, 1, At, B1); PG8_BAR; PG8_SCHED;
            } else {
            PG8_LDB(B0, 0, 0); PG8_SCHED; PG8_LDA(At, 0, 0); PG8_STAGE(PG8_SA(1, 1), a1 + hstep, voffA);
            PG8_WAIT_L(8); PG8_BAR; PG8_WAIT_L(0); PG8_MMA(0, 0, At, B0); PG8_BAR; PG8_SCHED;
            PG8_LDB(B1, 0, 1); PG8_STAGE(PG8_SB(0, 0), b2, voffB);
            PG8_BAR; PG8_WAIT_L(0); PG8_MMA(0, 1, At, B1); PG8_BAR;
            PG8_LDA(At, 0, 1); PG8_STAGE(PG8_SA(0, 0), a2, voffA);
            PG8_BAR; PG8_WAIT_L(0); PG8_MMA(1, 0, At, B0); PG8_BAR; PG8_SCHED;
            PG8_STAGE(PG8_SB(0, 1), b2 + hstep, voffB);
            PG8_WAIT_V(6); PG8_BAR; PG8_MMA(1, 1, At, B1); PG8_BAR;
            PG8_LDB(B0, 1, 0); PG8_SCHED; PG8_LDA(At, 1, 0); PG8_STAGE(PG8_SA(0, 1), a2 + hstep, voffA);
            PG8_WAIT_L(8); PG8_BAR; PG8_WAIT_L(0); PG8_MMA(0, 0, At, B0); PG8_BAR; PG8_SCHED;
            PG8_LDB(B1, 1, 1); PG8_STAGE(PG8_SB(1, 0), b3, voffB);
            PG8_BAR; PG8_WAIT_L(0); PG8_MMA(0, 1, At, B1); PG8_BAR;
            PG8_LDA(At, 1, 1); PG8_STAGE(PG8_SA(1, 0), a3, voffA);
            PG8_BAR; PG8_WAIT_L(0); PG8_MMA(1, 0, At, B0); PG8_BAR; PG8_SCHED;
            PG8_STAGE(PG8_SB(1, 1), b3 + hstep, voffB);
            PG8_WAIT_V(6); PG8_BAR; PG8_MMA(1, 1, At, B1); PG8_BAR;
            }
        }
        if constexpr (ALIGN_EPI) { if (wr == 0) PG8_BAR; }
        if constexpr (FP8) { asm volatile("s_nop 15\n\ts_nop 15" ::: "memory"); }
        if constexpr (!Epi::AFTER_DRAIN) { E(acc, cur, wr, wc, fr, fq); S.done(cur); }
        if (!has_next) break;
#pragma unroll
        for (int a = 0; a < 2; ++a)
#pragma unroll
            for (int b = 0; b < 2; ++b)
#pragma unroll
                for (int m = 0; m < 4; ++m)
#pragma unroll
                    for (int n = 0; n < 2; ++n) acc[a][b][m][n] = (f32x4){0.f, 0.f, 0.f, 0.f};
        cur = nxt; cA = nA; cB = nB; ++ui;
        if constexpr (ALIGN_EPI) { if (wr == 1) PG8_BAR; }
    }
    PG8_WAIT_V(0);
    if constexpr (!ALIGN_EPI) { if (wr == 0) PG8_BAR; }
    PG8_BAR;
    if constexpr (Epi::AFTER_DRAIN) { E.fused(acc, cur, wr, wc, fr, fq, lds, wid, lane); S.done(cur); }
#undef PG8_SA
#undef PG8_SB
#undef PG8_STAGE
#undef PG8_LDA
#undef PG8_LDB
#undef PG8_MMA
#undef PG8_WAIT_V
#undef PG8_WAIT_L
#undef PG8_BAR
#undef PG8_SCHED
}
}
#define GAS __attribute__((address_space(1)))
#define LAS __attribute__((address_space(3)))
typedef unsigned short bf16;
typedef unsigned v4u __attribute__((ext_vector_type(4)));
typedef float f32x4 __attribute__((ext_vector_type(4)));
typedef short bf16x8 __attribute__((ext_vector_type(8)));
typedef GAS unsigned gu32;
typedef GAS unsigned long long gu64;
#define RLX_AGENT __ATOMIC_RELAXED, __HIP_MEMORY_SCOPE_AGENT
#define LDS_WAIT() asm volatile("s_waitcnt lgkmcnt(0)" ::: "memory")
#define VM_WAIT() asm volatile("s_waitcnt vmcnt(0)" ::: "memory")
__device__ __forceinline__ unsigned long long rt() { return __builtin_amdgcn_s_memrealtime(); }
__device__ __forceinline__ unsigned f2bf(float f) { unsigned u = __builtin_bit_cast(unsigned, f); return (u + 0x7fffu + ((u >> 16) & 1u)) >> 16; }
__device__ __forceinline__ unsigned pk2(float lo, float hi) { return f2bf(lo) | (f2bf(hi) << 16); }
#define XB_TMO      128
#define XB_XCNT(j)  (256  + 64 * (j))
#define XB_XSUB(j)  (1280 + 64 * (j))
#define XB_XGEN(j)  (2304 + 64 * (j))
#define XB_TOP      3328
#define XB_TOPGEN   3392
#define XCD_BAR_WORDS 3456
#define XB_SPIN_CAP (1u << 18)

__device__ __forceinline__ unsigned xb_ld(unsigned* p)              { return __hip_atomic_load(p, __ATOMIC_RELAXED, __HIP_MEMORY_SCOPE_AGENT); }
__device__ __forceinline__ unsigned xb_add(unsigned* p, unsigned v) { return __hip_atomic_fetch_add(p, v, __ATOMIC_RELAXED, __HIP_MEMORY_SCOPE_AGENT); }
__device__ __forceinline__ unsigned xb_xcc_id() { return (unsigned)__builtin_amdgcn_s_getreg((3 << 11) | 20) & 0xFu; }
#define XB_SPIN(cond, bar) do { unsigned _sp = 0; while (cond) { __builtin_amdgcn_s_sleep(1); \
    if ((++_sp & 255u) == 0u) { if (xb_ld(&(bar)[XB_TMO])) break; if (_sp > XB_SPIN_CAP) { atomicAdd(&(bar)[XB_TMO], 1u); break; } } } } while (0)

struct XcdBarrier {
    unsigned* bar; unsigned x;
    volatile LAS unsigned* st;
};

__device__ __forceinline__ XcdBarrier xcd_barrier_post(unsigned* bar, volatile LAS unsigned* st) {
    XcdBarrier b; b.bar = bar; b.x = xb_xcc_id(); b.st = st;
    if (threadIdx.x == 0) (void)xb_add(&bar[XB_XCNT(b.x)], 1u);
    return b;
}
__device__ __forceinline__ void xcd_barrier_complete(unsigned* bar, unsigned x, unsigned& nloc, unsigned& nx) {
    const unsigned G = gridDim.x * gridDim.y * gridDim.z;
    unsigned sum, cnt, mine, sp = 0u;
    for (;;) {
        sum = 0u; cnt = 0u; mine = 0u;
#pragma unroll
        for (unsigned j = 0; j < 16; ++j) { const unsigned c = xb_ld(&bar[XB_XCNT(j)]); sum += c; cnt += (c > 0u) ? 1u : 0u; mine = (j == x) ? c : mine; }
        if (sum == G) break;
        __builtin_amdgcn_s_sleep(1);
        if ((++sp & 255u) == 0u) { if (xb_ld(&bar[XB_TMO])) break; if (sp > XB_SPIN_CAP) { atomicAdd(&bar[XB_TMO], 1u); break; } }
    }
    nloc = mine > 0u ? mine : 1u; nx = cnt > 0u ? cnt : 1u;
}

__device__ __forceinline__ void xcd_barrier(const XcdBarrier& b, const bool t0  ) {
    asm volatile("s_waitcnt vmcnt(0)" ::: "memory");
    __syncthreads();
    if (t0) {
        unsigned* bar = b.bar;
        __builtin_amdgcn_s_waitcnt(0);
        unsigned nloc = b.st[0], nx = b.st[1];
        if (nloc == 0u) { xcd_barrier_complete(bar, b.x, nloc, nx); b.st[0] = nloc; b.st[1] = nx; }
        const unsigned old = xb_add(&bar[XB_XSUB(b.x)], 1u);
        const unsigned gen = old / nloc;
        if (old + 1u == (gen + 1u) * nloc) {
            __builtin_amdgcn_fence(__ATOMIC_RELEASE, "agent");
            asm volatile("s_waitcnt vmcnt(0)" ::: "memory");
            const unsigned og = xb_add(&bar[XB_TOP], 1u);
            const unsigned tg = og / nx;
            if (og + 1u == (tg + 1u) * nx) xb_add(&bar[XB_TOPGEN], 1u);
            else XB_SPIN(xb_ld(&bar[XB_TOPGEN]) == tg, bar);
            __builtin_amdgcn_fence(__ATOMIC_ACQUIRE, "agent");
            xb_add(&bar[XB_XGEN(b.x)], 1u);
            asm volatile("s_waitcnt vmcnt(0)" ::: "memory");
        } else {
            XB_SPIN(xb_ld(&bar[XB_XGEN(b.x)]) == gen, bar);
            __builtin_amdgcn_fence(__ATOMIC_ACQUIRE, "agent");
            asm volatile("s_waitcnt vmcnt(0)" ::: "memory");
        }
    }
    __syncthreads();
}
#include <hip/hip_bf16.h>
#include <cmath>
namespace attn_body {
using bf16=__hip_bfloat16;
using bf16x8=__attribute__((ext_vector_type(8)))short;
using s16x4=__attribute__((ext_vector_type(4)))short;
using f32x16=__attribute__((ext_vector_type(16)))float;
using u32x4=__attribute__((ext_vector_type(4)))unsigned;
constexpr int SEQ=2048,D=64,PQ=64,PK=64,PV=128,PO=1024;
constexpr int NW=8,QBLK=32,QB=QBLK*NW,KVBLK=64,NQB=SEQ/QB;
constexpr int ATTN_UNIT_ROWS=QB;
__device__ __forceinline__ int crow(int r,int hi){return (r&3)+8*(r>>2)+4*hi;}
#define SBAR() __builtin_amdgcn_sched_barrier(0)
__device__ __forceinline__ void cmask(f32x16&p0,f32x16&p1,int jb,int qrel,int hi){
  const float NEG=-INFINITY; int kb=64*jb+4*hi;
  #pragma unroll
  for(int r=0;r<16;++r){int kv=kb+(r&3)+8*(r>>2); if(kv>qrel)p0[r]=NEG; if(kv+32>qrel)p1[r]=NEG;}
}

constexpr int NSLOT=3, SLOTB=8192;
constexpr int LDS_K=0, LDS_V=NSLOT*SLOTB, LDS_WS=2*NSLOT*SLOTB, LDS_OST=LDS_WS+NW*64*4, LDS_BYTES=LDS_OST+NW*4096;
constexpr float C2=0.125f*1.4426950408889634f;
__device__ __forceinline__ void glds16(const void*gsrc,unsigned lds_dst){unsigned keep;
  asm volatile("s_mov_b32 %0, m0\n\ts_mov_b32 m0, %2\n\ts_nop 0\n\tglobal_load_lds_dwordx4 %1, off\n\ts_mov_b32 m0, %0":"=&s"(keep):"v"(gsrc),"s"(lds_dst):"memory");}
__device__ __forceinline__ float max3f(float a,float b,float c){float r;asm("v_max3_f32 %0, %1, %2, %3":"=v"(r):"v"(a),"v"(b),"v"(c));return r;}
__device__ __forceinline__ float max2f(float a,float b){float r;asm("v_max_f32_e32 %0, %1, %2":"=v"(r):"v"(a),"v"(b));return r;}
__device__ __forceinline__ float fadd_s(float a,float b){float r;asm("v_add_f32_e32 %0, %1, %2":"=v"(r):"v"(a),"v"(b));return r;}
__device__ __forceinline__ float fsub_s(float a,float b){float r;asm("v_sub_f32_e32 %0, %1, %2":"=v"(r):"v"(a),"v"(b));return r;}
typedef float f32x2_t __attribute__((ext_vector_type(2))); typedef __bf16 bf16x2_t __attribute__((ext_vector_type(2)));
__device__ __forceinline__ unsigned cvtpk_s(float lo,float hi){f32x2_t v={lo,hi};bf16x2_t b=__builtin_convertvector(v,bf16x2_t);return __builtin_bit_cast(unsigned,b);}
#define WAIT_BAR(N) asm volatile("s_waitcnt vmcnt(" #N ") lgkmcnt(0)\n\ts_barrier":::"memory")

__device__ __forceinline__ void qkt(f32x16&p0,f32x16&p1,const char*Kslot,const bf16x8*qr,const f32x16&negm,int r32,int hi){
  const char*kb=Kslot+hi*1024+r32*16;
  #pragma unroll
  for(int d0=0;d0<4;++d0){
    const bf16x8 b0=*reinterpret_cast<const bf16x8*>(kb+d0*2048);
    const bf16x8 b1=*reinterpret_cast<const bf16x8*>(kb+d0*2048+512);
    if(d0==0){p0=__builtin_amdgcn_mfma_f32_32x32x16_bf16(b0,qr[0],negm,0,0,0);p1=__builtin_amdgcn_mfma_f32_32x32x16_bf16(b1,qr[0],negm,0,0,0);}
    else{p0=__builtin_amdgcn_mfma_f32_32x32x16_bf16(b0,qr[d0],p0,0,0,0);p1=__builtin_amdgcn_mfma_f32_32x32x16_bf16(b1,qr[d0],p1,0,0,0);}}
}
typedef __attribute__((address_space(3))) const char* lds_cptr;
typedef short v4i16_t __attribute__((ext_vector_type(4)));
__device__ __forceinline__ void kload8(bf16x8*kf,lds_cptr kp){
  kf[0]=*(const __attribute__((address_space(3))) bf16x8*)(kp);      kf[1]=*(const __attribute__((address_space(3))) bf16x8*)(kp+512);
  kf[2]=*(const __attribute__((address_space(3))) bf16x8*)(kp+2048); kf[3]=*(const __attribute__((address_space(3))) bf16x8*)(kp+2560);
  kf[4]=*(const __attribute__((address_space(3))) bf16x8*)(kp+4096); kf[5]=*(const __attribute__((address_space(3))) bf16x8*)(kp+4608);
  kf[6]=*(const __attribute__((address_space(3))) bf16x8*)(kp+6144); kf[7]=*(const __attribute__((address_space(3))) bf16x8*)(kp+6656);
}
__device__ __forceinline__ void kload2(bf16x8*kf,lds_cptr kp,int j){ kf[2*j]=*(const __attribute__((address_space(3))) bf16x8*)(kp+j*2048); kf[2*j+1]=*(const __attribute__((address_space(3))) bf16x8*)(kp+j*2048+512); }
__device__ __forceinline__ s16x4 vtr(lds_cptr p){ return __builtin_bit_cast(s16x4,__builtin_amdgcn_ds_read_tr16_b64_v4i16((__attribute__((address_space(3))) v4i16_t*)p)); }
__device__ __forceinline__ float rowmax(const f32x16&p0,const f32x16&p1){
  float a=max3f(p0[0],p0[1],p1[0]),b=max3f(p0[2],p0[3],p1[1]);a=max3f(a,p1[2],p1[3]);
  #pragma unroll
  for(int r=4;r<16;r+=4){a=max3f(a,p0[r],p0[r+1]);b=max3f(b,p0[r+2],p0[r+3]);a=max3f(a,p1[r],p1[r+1]);b=max3f(b,p1[r+2],p1[r+3]);}
  const float m=max2f(a,b);
  auto rr=__builtin_amdgcn_permlane32_swap(__float_as_uint(m),__float_as_uint(m),false,false);
  return max2f(__uint_as_float(rr[0]),__uint_as_float(rr[1]));
}
__device__ __forceinline__ void pv(f32x16*o,int vb,bf16x8 pa0,bf16x8 pa1,bf16x8 pa2,bf16x8 pa3){
  #pragma unroll
  for(int d0=0;d0<2;++d0){s16x4 lo[4],hi[4];
    #pragma unroll
    for(int ks=0;ks<4;++ks){
      asm volatile("ds_read_b64_tr_b16 %0,%1 offset:%c2":"=&v"(lo[ks]):"v"(vb),"i"(d0*4096+ks*1024):"memory");
      asm volatile("ds_read_b64_tr_b16 %0,%1 offset:%c2":"=&v"(hi[ks]):"v"(vb),"i"(d0*4096+ks*1024+512):"memory");}
    asm volatile("s_waitcnt lgkmcnt(0)":::"memory");SBAR();
    #define PK(k) (bf16x8){lo[k][0],lo[k][1],lo[k][2],lo[k][3],hi[k][0],hi[k][1],hi[k][2],hi[k][3]}
    o[d0]=__builtin_amdgcn_mfma_f32_32x32x16_bf16(pa0,PK(0),o[d0],0,0,0);
    o[d0]=__builtin_amdgcn_mfma_f32_32x32x16_bf16(pa1,PK(1),o[d0],0,0,0);
    o[d0]=__builtin_amdgcn_mfma_f32_32x32x16_bf16(pa2,PK(2),o[d0],0,0,0);
    o[d0]=__builtin_amdgcn_mfma_f32_32x32x16_bf16(pa3,PK(3),o[d0],0,0,0);
    #undef PK
  }
}

#ifndef ATTN_STORE16
#define ATTN_STORE16(p,v) (*(u32x4*)(p)=(v))
#endif
template<int THRL> __device__ __forceinline__ void attn_unit(const bf16*Qh,const bf16*__restrict__ Kh,const bf16*__restrict__ Vh,bf16*Oh,int q0,char*shm,int tid_in){
  const int tid=tid_in,lane=tid&63,r32=lane&31,hi=lane>>5; const int wid=__builtin_amdgcn_readfirstlane(tid>>6);
  const bf16*Qw=Qh+(long)(q0+wid*QBLK)*PQ;
  const unsigned lds0=(unsigned)(uintptr_t)shm;
  float*wsf=(float*)(shm+LDS_WS)+wid*64;
  const bf16*ksrc=Kh+(long)lane*PK+wid*8;
  const bf16*vsrc=Vh+(long)(16*(wid&3)+(lane>>2))*PV+(wid>>2)*32+(lane&3)*8;
  const unsigned kdst=lds0+LDS_K+wid*1024, vdst=lds0+LDS_V+wid*1024;
  #define DMA_K(t,slot) glds16(ksrc+(long)(t)*KVBLK*PK,(unsigned)__builtin_amdgcn_readfirstlane(kdst+(slot)))
  #define DMA_V(t,slot) glds16(vsrc+(long)(t)*KVBLK*PV,(unsigned)__builtin_amdgcn_readfirstlane(vdst+(slot)))
  const int vb0=(int)(lds0+LDS_V)+((lane>>4)&1)*32+(lane&3)*8+(4*hi+((lane&15)>>2))*64;
  const char*Kbase=shm+LDS_K; bf16x8 kf[8];
  const lds_cptr shm3=(lds_cptr)shm; const lds_cptr kp0=shm3+LDS_K+hi*1024+r32*16; const lds_cptr vp0=shm3+LDS_V+((lane>>4)&1)*32+(lane&3)*8+(4*hi+((lane&15)>>2))*64;
  constexpr int NT=SEQ/KVBLK;
  DMA_K(0,0);DMA_V(0,0);DMA_K(1,SLOTB);
  bf16x8 qr[4];
  #pragma unroll
  for(int d0=0;d0<4;++d0)qr[d0]=*reinterpret_cast<const bf16x8*>(&Qw[(long)r32*PQ+d0*16+hi*8]);
  float mhat=0.f,l_reg=0.f;f32x16 o[2];o[0]=f32x16{};o[1]=f32x16{};f32x16 negm=f32x16{};asm volatile("":"+v"(negm));
  #define CMASK(P0,P1,t) do{}while(0)
  bool resc=false;
  #define START(P0,P1) do{ const float rm=rowmax(P0,P1); resc=false; \
    { const float dl=rm; mhat=fadd_s(mhat,dl); \
      _Pragma("unroll") for(int r=0;r<16;++r){P0[r]=fsub_s(P0[r],dl);P1[r]=fsub_s(P1[r],dl);} \
      _Pragma("unroll") for(int r=0;r<16;++r)negm[r]=-mhat; asm volatile("":"+v"(negm)); } \
    _Pragma("unroll") for(int r=0;r<16;++r)P0[r]=__builtin_amdgcn_exp2f(P0[r]); }while(0)
  #define RESC() do{ if(resc){ asm volatile("s_waitcnt lgkmcnt(0)":::"memory"); \
      _Pragma("unroll") for(int d_=0;d_<2;++d_) _Pragma("unroll") for(int r=0;r<16;++r)o[d_][r]*=wsf[crow(r,hi)]; } }while(0)
  f32x16 pA0,pA1,pB0,pB1;
  int sl_prev=0,sl_cur=0,sl_next=SLOTB;
  #define ROT() do{sl_prev=sl_cur;sl_cur=sl_next;sl_next=(sl_next==(NSLOT-1)*SLOTB)?0:sl_next+SLOTB;}while(0)
  DMA_K(2,2*SLOTB);
  WAIT_BAR(3);
  qkt(pA0,pA1,Kbase,qr,negm,r32,hi);asm volatile("s_nop 15\n\ts_nop 7":"+v"(pA0),"+v"(pA1));CMASK(pA0,pA1,0);
  START(pA0,pA1);
  _Pragma("unroll") for(int r=0;r<16;++r)pA1[r]=__builtin_amdgcn_exp2f(pA1[r]);
  WAIT_BAR(0);
  DMA_K(3,0);DMA_V(1,SLOTB);
  ROT();
  kload8(kf,kp0+sl_cur);
  WAIT_BAR(2);
  s16x4 vlo[8],vhi[8]; u32x4 pw0,pw1,pw2,pw3;
  #define PKW(P,B) cvtpk_s(P[B],P[B+1])
  #define PAF(k) __builtin_bit_cast(bf16x8,pw##k)
  #define VFR(i) (bf16x8){vlo[i][0],vlo[i][1],vlo[i][2],vlo[i][3],vhi[i][0],vhi[i][1],vhi[i][2],vhi[i][3]}
  #define PIN(x) asm volatile("":"+v"(x))
  #define MX3(a,b,c) __builtin_fmaxf(__builtin_fmaxf((a),(b)),(c))
  #define GAPA(MF,A0,A1,A2,A3,W0,W1,PW) do{ MF; sacc+=A0; sacc+=A1; sacc+=A2; sacc+=A3; PIN(sacc); W0; W1; PIN(PW); SBAR(); }while(0)
  #define EX(v) __builtin_amdgcn_exp2f(v)
  #define GAPB(MF,X,B) do{ MF; X[B]=EX(X[B]); X[B+1]=EX(X[B+1]); X[B+2]=EX(X[B+2]); X[B+3]=EX(X[B+3]); PIN(X); SBAR(); }while(0)
  #define VRD(i) do{ vlo[i]=vtr(vp_+(((i)>>2)*4096+((i)&3)*1024)); vhi[i]=vtr(vp_+(((i)>>2)*4096+((i)&3)*1024+512)); }while(0)
  #define KRD(G,j) do{ if(G){ kload2(kf,kp0+sl_next,j); SBAR(); } }while(0)
  #define STEP(C0,C1,P0,P1,t,GK,GV,GL) do{ SBAR(); \
    const lds_cptr vp_=vp0+sl_prev; \
    VRD(0); SBAR(); float sacc=(P0[0]+P0[1]); \
    GAPA(C0=__builtin_amdgcn_mfma_f32_32x32x16_bf16(kf[0],qr[0],negm,0,0,0), P0[2],P0[3],P0[4],P0[5],     pw0[0]=PKW(P0,0), pw0[1]=PKW(P0,2), pw0); \
    VRD(4); SBAR(); GAPA(C1=__builtin_amdgcn_mfma_f32_32x32x16_bf16(kf[1],qr[0],negm,0,0,0), P0[6],P0[7],P0[8],P0[9],     pw0[2]=PKW(P0,4), pw0[3]=PKW(P0,6), pw0); \
    VRD(1); SBAR(); GAPA(C0=__builtin_amdgcn_mfma_f32_32x32x16_bf16(kf[2],qr[1],C0,0,0,0),   P0[10],P0[11],P0[12],P0[13], pw1[0]=PKW(P0,8), pw1[1]=PKW(P0,10), pw1); \
    VRD(5); SBAR(); GAPA(C1=__builtin_amdgcn_mfma_f32_32x32x16_bf16(kf[3],qr[1],C1,0,0,0),   P0[14],P0[15],P1[0],P1[1],   pw1[2]=PKW(P0,12),pw1[3]=PKW(P0,14), pw1); \
    VRD(2); SBAR(); GAPA(C0=__builtin_amdgcn_mfma_f32_32x32x16_bf16(kf[4],qr[2],C0,0,0,0),   P1[2],P1[3],P1[4],P1[5],     pw2[0]=PKW(P1,0), pw2[1]=PKW(P1,2), pw2); \
    VRD(6); SBAR(); GAPA(C1=__builtin_amdgcn_mfma_f32_32x32x16_bf16(kf[5],qr[2],C1,0,0,0),   P1[6],P1[7],P1[8],P1[9],     pw2[2]=PKW(P1,4), pw2[3]=PKW(P1,6), pw2); \
    VRD(3); SBAR(); GAPA(C0=__builtin_amdgcn_mfma_f32_32x32x16_bf16(kf[6],qr[3],C0,0,0,0),   P1[10],P1[11],P1[12],P1[13], pw3[0]=PKW(P1,8), pw3[1]=PKW(P1,10), pw3); \
    VRD(7); SBAR(); GAPA(C1=__builtin_amdgcn_mfma_f32_32x32x16_bf16(kf[7],qr[3],C1,0,0,0),   P1[14],P1[15],0.f,0.f,       pw3[2]=PKW(P1,12),pw3[3]=PKW(P1,14), pw3); \
    l_reg+=sacc; \
    if(GK){DMA_K((t)+3,sl_cur);} if(GV){DMA_V((t)+1,sl_next);} \
    CMASK(C0,C1,t); \
    { float a=MX3(C0[0],C0[1],C1[0]),b=MX3(C0[2],C0[3],C1[1]); a=MX3(a,C1[2],C1[3]); \
      _Pragma("unroll") for(int r=4;r<16;r+=4){a=MX3(a,C0[r],C0[r+1]);b=MX3(b,C0[r+2],C0[r+3]);a=MX3(a,C1[r],C1[r+1]);b=MX3(b,C1[r+2],C1[r+3]);} \
      float rm=__builtin_fmaxf(a,b); { auto rr=__builtin_amdgcn_permlane32_swap(__float_as_uint(rm),__float_as_uint(rm),false,false); rm=__builtin_fmaxf(__uint_as_float(rr[0]),__uint_as_float(rr[1])); } \
      resc=false; \
      if(__builtin_expect(__any(rm>(float)THRL),0)){ const float dl=__builtin_fmaxf(rm,0.f); mhat+=dl; \
        _Pragma("unroll") for(int r=0;r<16;++r){C0[r]-=dl;C1[r]-=dl;} \
        _Pragma("unroll") for(int r=0;r<16;++r)negm[r]=-mhat; asm volatile("":"+v"(negm)); \
        const float f=__builtin_amdgcn_exp2f(-dl); l_reg*=f; if(hi==0)wsf[r32]=f; resc=true; } } \
    SBAR(); \
    GAPB(o[0]=__builtin_amdgcn_mfma_f32_32x32x16_bf16(PAF(0),VFR(0),o[0],0,0,0), C0,0); \
    GAPB(o[1]=__builtin_amdgcn_mfma_f32_32x32x16_bf16(PAF(0),VFR(4),o[1],0,0,0), C0,4); \
    KRD(GL,0); GAPB(o[0]=__builtin_amdgcn_mfma_f32_32x32x16_bf16(PAF(1),VFR(1),o[0],0,0,0), C0,8); \
    KRD(GL,1); GAPB(o[1]=__builtin_amdgcn_mfma_f32_32x32x16_bf16(PAF(1),VFR(5),o[1],0,0,0), C0,12); \
    KRD(GL,2); GAPB(o[0]=__builtin_amdgcn_mfma_f32_32x32x16_bf16(PAF(2),VFR(2),o[0],0,0,0), C1,0); \
    KRD(GL,3); GAPB(o[1]=__builtin_amdgcn_mfma_f32_32x32x16_bf16(PAF(2),VFR(6),o[1],0,0,0), C1,4); \
    GAPB(o[0]=__builtin_amdgcn_mfma_f32_32x32x16_bf16(PAF(3),VFR(3),o[0],0,0,0), C1,8); \
    GAPB(o[1]=__builtin_amdgcn_mfma_f32_32x32x16_bf16(PAF(3),VFR(7),o[1],0,0,0), C1,12); \
    }while(0)
  int t=1;
  #undef CMASK
  #define CMASK(P0,P1,t) do{}while(0)
  for(;t+5<NT;t+=2){
    STEP(pB0,pB1,pA0,pA1,t,true,true,true);     WAIT_BAR(2); RESC(); ROT();
    STEP(pA0,pA1,pB0,pB1,t+1,true,true,true);   WAIT_BAR(2); RESC(); ROT();
  }
  #undef CMASK
  #define CMASK(P0,P1,t) do{}while(0)
  #define ENDW(tt) do{ if((tt)+3<NT){WAIT_BAR(2);} else if((tt)+2<NT){WAIT_BAR(1);} else {WAIT_BAR(0);} }while(0)
  for(;t+1<NT;t+=2){
    STEP(pB0,pB1,pA0,pA1,t,(t+3<NT),(t+1<NT),(t+1<NT));       ENDW(t);   RESC(); ROT();
    STEP(pA0,pA1,pB0,pB1,t+1,(t+4<NT),(t+2<NT),(t+2<NT));     ENDW(t+1); RESC(); ROT();
  }
  STEP(pB0,pB1,pA0,pA1,NT-1,false,false,false); RESC();
  { float sacc=pB0[0]+pB0[1]; _Pragma("unroll") for(int r=2;r<16;++r)sacc+=pB0[r]; _Pragma("unroll") for(int r=0;r<16;++r)sacc+=pB1[r]; l_reg+=sacc;
    pw0=(u32x4){PKW(pB0,0),PKW(pB0,2),PKW(pB0,4),PKW(pB0,6)};pw1=(u32x4){PKW(pB0,8),PKW(pB0,10),PKW(pB0,12),PKW(pB0,14)};pw2=(u32x4){PKW(pB1,0),PKW(pB1,2),PKW(pB1,4),PKW(pB1,6)};pw3=(u32x4){PKW(pB1,8),PKW(pB1,10),PKW(pB1,12),PKW(pB1,14)};
    SBAR(); pv(o,vb0+sl_cur,PAF(0),PAF(1),PAF(2),PAF(3)); }
  #undef PKW
  #undef PAF
  #undef VFR
  #undef PIN
  #undef MX3
  #undef GAPA
  #undef GAPB
  #undef EX
  #undef VRD
  #undef KRD
  #undef STEP
  #undef ENDW
  {auto rr=__builtin_amdgcn_permlane32_swap(__float_as_uint(l_reg),__float_as_uint(l_reg),false,false);l_reg=__uint_as_float(rr[0])+__uint_as_float(rr[1]);}
  if(hi==0)wsf[32+r32]=l_reg;asm volatile("s_waitcnt lgkmcnt(0)":::"memory");
  float rli[16];
  #pragma unroll
  for(int r=0;r<16;++r)rli[r]=__builtin_amdgcn_rcpf(wsf[32+crow(r,hi)]);
  bf16*Ow=Oh+(long)(q0+wid*QBLK)*PO;
  { bf16*stg=(bf16*)(shm+LDS_OST)+wid*2048;
    #pragma unroll
    for(int r=0;r<16;++r){const int orow=crow(r,hi);
      #pragma unroll
      for(int d0=0;d0<2;++d0)stg[orow*64+d0*32+r32]=__float2bfloat16(o[d0][r]*rli[r]);}
    asm volatile("s_waitcnt lgkmcnt(0)":::"memory");
    #pragma unroll
    for(int i=0;i<4;++i){const int row=i*8+(lane>>3),ch=lane&7; const u32x4 v=*(const u32x4*)(stg+row*64+ch*8); ATTN_STORE16(Ow+(long)row*PO+ch*8,v);} }
  asm volatile("s_waitcnt lgkmcnt(0)\n\ts_barrier":::"memory");
  #undef DMA_K
  #undef DMA_V
  #undef CMASK
  #undef START
  #undef RESC
  #undef ROT
}
constexpr int ATTN_LDS_BYTES=LDS_BYTES;
#undef SBAR
#undef WAIT_BAR
}

namespace wattn {
using bf16x8 = __attribute__((ext_vector_type(8))) short;
using s16x4 = __attribute__((ext_vector_type(4))) short;
using f32x16 = __attribute__((ext_vector_type(16))) float;
using u32x4 = __attribute__((ext_vector_type(4))) unsigned;
typedef float f32x2_t __attribute__((ext_vector_type(2))); typedef __bf16 bf16x2_t __attribute__((ext_vector_type(2)));
__device__ __forceinline__ unsigned cvtpk(float lo, float hi) { f32x2_t v = {lo, hi}; bf16x2_t b = __builtin_convertvector(v, bf16x2_t); return __builtin_bit_cast(unsigned, b); }
__device__ __forceinline__ int crow(int r, int hi) { return (r & 3) + 8 * (r >> 2) + 4 * hi; }
typedef __attribute__((address_space(3))) char* lds_ptr;
typedef short v4i16_t __attribute__((ext_vector_type(4)));
__device__ __forceinline__ s16x4 vtr(lds_ptr p) { return __builtin_bit_cast(s16x4, __builtin_amdgcn_ds_read_tr16_b64_v4i16((__attribute__((address_space(3))) v4i16_t*)p)); }
template <class Desc> __device__ __forceinline__ void wave_attn(const Desc& ds, lds_ptr wl, int lane) {
    typedef __attribute__((address_space(3))) u32x4 lds_u32x4; typedef __attribute__((address_space(3))) bf16x8 lds_bf16x8;
    const int r32 = lane & 31, hi = lane >> 5, lrow = lane >> 3, lch = lane & 7;
    bf16x8 qf[4];
    { const unsigned short* qp = ds.qptr(r32);
#pragma unroll
      for (int d0 = 0; d0 < 4; ++d0) qf[d0] = *(const bf16x8*)(qp + 16 * d0 + 8 * hi); }
    f32x16 o0, o1;
#pragma unroll
    for (int r = 0; r < 16; ++r) { o0[r] = 0.f; o1[r] = 0.f; }
    float l = 0.f; const float off = ds.off;
    const int nt = ds.ntiles();
    u32x4 kA[4], vA[4], kB[4], vB[4];
#define WATTN_LOAD(KX, VX, T) do { _Pragma("unroll") for (int i = 0; i < 4; ++i) { const unsigned short* p_ = ds.row_ptr((T), lrow + 8 * i) + lch * 8; KX[i] = *(const u32x4*)p_; VX[i] = *(const u32x4*)(p_ + Desc::VOFF); } } while (0)
    WATTN_LOAD(kA, vA, 0); if (nt > 1) WATTN_LOAD(kB, vB, 1);
    const lds_ptr kw = wl + lrow * 144 + lch * 16, vw = wl + 4608 + lrow * 128 + lch * 16;
    const lds_ptr kr = wl + r32 * 144 + hi * 16;
    const lds_ptr vr = wl + 4608 + (4 * hi + ((lane & 15) >> 2)) * 128 + ((lane >> 4) & 1) * 32 + (lane & 3) * 8;
#define WATTN_STEP(KX, VX, T) do { const int t = (T); \
        asm volatile("" ::: "memory"); \
        _Pragma("unroll") for (int i = 0; i < 4; ++i) { *(lds_u32x4*)(kw + 1152 * i) = KX[i]; *(lds_u32x4*)(vw + 1024 * i) = VX[i]; } \
        asm volatile("" ::: "memory"); \
        if (t + 2 < nt) WATTN_LOAD(KX, VX, t + 2); \
        bf16x8 kf[4]; \
        _Pragma("unroll") for (int d0 = 0; d0 < 4; ++d0) kf[d0] = *(const lds_bf16x8*)(kr + 32 * d0); \
        f32x16 p; \
        _Pragma("unroll") for (int r = 0; r < 16; ++r) p[r] = -off; \
        _Pragma("unroll") for (int d0 = 0; d0 < 4; ++d0) p = __builtin_amdgcn_mfma_f32_32x32x16_bf16(kf[d0], qf[d0], p, 0, 0, 0); \
        int lo, hb; ds.bounds(t, r32, lo, hb); \
        if (Desc::HAS_BIAS) { const __attribute__((address_space(3))) float* bb = ds.bias_base(t, r32) + 4 * hi; \
            _Pragma("unroll") for (int r = 0; r < 16; ++r) p[r] += bb[(r & 3) + 8 * (r >> 2)]; } \
        if (!__all(lo <= 0 && hb >= 31)) { const unsigned w = (unsigned)(hb - lo); const int dd = 4 * hi - lo; \
            _Pragma("unroll") for (int r = 0; r < 16; ++r) p[r] = ((unsigned)((r & 3) + 8 * (r >> 2) + dd) <= w) ? p[r] : -INFINITY; } \
        { float rs = 0.f; \
          _Pragma("unroll") for (int r = 0; r < 16; ++r) { p[r] = __builtin_amdgcn_exp2f(p[r]); rs += p[r]; } \
          rs += __shfl_xor(rs, 32); l += rs; } \
        u32x4 pw0, pw1; \
        pw0 = (u32x4){cvtpk(p[0], p[1]), cvtpk(p[2], p[3]), cvtpk(p[4], p[5]), cvtpk(p[6], p[7])}; \
        pw1 = (u32x4){cvtpk(p[8], p[9]), cvtpk(p[10], p[11]), cvtpk(p[12], p[13]), cvtpk(p[14], p[15])}; \
        const bf16x8 pa0 = __builtin_bit_cast(bf16x8, pw0), pa1 = __builtin_bit_cast(bf16x8, pw1); \
        _Pragma("unroll") for (int s = 0; s < 2; ++s) { \
            _Pragma("unroll") for (int dh = 0; dh < 2; ++dh) { \
                const s16x4 lo4 = vtr(vr + (16 * s) * 128 + dh * 64), hh = vtr(vr + (16 * s + 8) * 128 + dh * 64); \
                const bf16x8 vf = (bf16x8){lo4[0], lo4[1], lo4[2], lo4[3], hh[0], hh[1], hh[2], hh[3]}; \
                if (dh == 0) o0 = __builtin_amdgcn_mfma_f32_32x32x16_bf16(s == 0 ? pa0 : pa1, vf, o0, 0, 0, 0); \
                else o1 = __builtin_amdgcn_mfma_f32_32x32x16_bf16(s == 0 ? pa0 : pa1, vf, o1, 0, 0, 0); \
            } } \
        asm volatile("" ::: "memory"); } while (0)
    for (int tt = 0; tt < nt; tt += 2) {
        WATTN_STEP(kA, vA, tt);
        if (tt + 1 < nt) WATTN_STEP(kB, vB, tt + 1);
    }
#undef WATTN_STEP
#undef WATTN_LOAD
    const float rl = 1.0f / l; const lds_ptr ow = wl + 4608;
    int hi_e = hi, r32_e = r32; asm volatile("" : "+v"(hi_e), "+v"(r32_e));
    asm volatile("" ::: "memory");
#pragma unroll
    for (int r = 0; r < 16; ++r) { const int qi = crow(r, hi_e); const float a = __shfl(rl, qi);
        *(__attribute__((address_space(3))) unsigned short*)(ow + qi * 128 + r32_e * 2) = (unsigned short)(cvtpk(o0[r] * a, 0.f) & 0xffffu);
        *(__attribute__((address_space(3))) unsigned short*)(ow + qi * 128 + 64 + r32_e * 2) = (unsigned short)(cvtpk(o1[r] * a, 0.f) & 0xffffu); }
    asm volatile("" ::: "memory");
#pragma unroll
    for (int i = 0; i < 4; ++i) { const int row = lrow + 8 * i;
        const u32x4 w = *(const lds_u32x4*)(ow + row * 128 + lch * 16); ds.store16(row, lch, w); }
    if (hi == 0) ds.lse(r32, (off + __builtin_amdgcn_logf(l)) * 0.6931471805599453f);
    asm volatile("" ::: "memory");
}
}
namespace dattn {
using bf16x8 = __attribute__((ext_vector_type(8))) short;
using s16x4  = __attribute__((ext_vector_type(4))) short;
using f32x16 = __attribute__((ext_vector_type(16))) float;
using u32x4  = __attribute__((ext_vector_type(4))) unsigned;
typedef unsigned short bf16r;
constexpr int NW = 8, QBLK = 32, KVBLK = 64, SEQ = 2048, DQK = 64, DV = 128;
constexpr int SHM_V = KVBLK * DV * 2, SHM_K = KVBLK * DQK * 2, OFF_K = 2 * SHM_V, OFF_WS = OFF_K + 2 * SHM_K, OFF_STASH = OFF_WS + NW * 64 * 4, LDS_BYTES = OFF_STASH + 256 * DV * 2;
constexpr float THRL = 8.f;
#define DA_KSWZ(row, colB) ((row) * 128 + ((colB) ^ (((row) & 7) << 4)))
#define DA_SBAR() __builtin_amdgcn_sched_barrier(0)
__device__ __forceinline__ int crow(int r, int hi) { return (r & 3) + 8 * (r >> 2) + 4 * hi; }
__device__ __forceinline__ int opqv(int v) { asm volatile("" : "+v"(v)); return v; }
__device__ __forceinline__ unsigned cvtpk(float lo, float hi) { unsigned r; asm volatile("v_cvt_pk_bf16_f32 %0, %1, %2" : "=v"(r) : "v"(lo), "v"(hi)); return r; }
__device__ __forceinline__ void partialSM(f32x16& p0) {
#pragma unroll
  for (int r = 0; r < 16; ++r) p0[r] = __builtin_amdgcn_exp2f(p0[r]);
}
__device__ __forceinline__ void finishSM(f32x16& p0, f32x16& p1, float& l_reg, bf16x8& pa0, bf16x8& pa1, bf16x8& pa2, bf16x8& pa3) {
#pragma unroll
  for (int r = 0; r < 16; ++r) p1[r] = __builtin_amdgcn_exp2f(p1[r]);
  typedef float f32x2_ __attribute__((ext_vector_type(2)));
  f32x2_ s2 = {0.f, 0.f};
#pragma unroll
  for (int r = 0; r < 16; r += 2) { s2 += (f32x2_){p0[r], p0[r + 1]}; s2 += (f32x2_){p1[r], p1[r + 1]}; }
  float ps = s2.x + s2.y;
  { auto rr = __builtin_amdgcn_permlane32_swap(__float_as_uint(ps), __float_as_uint(ps), false, false);
    ps = __uint_as_float(rr[0]) + __uint_as_float(rr[1]); }
  l_reg += ps;
#define DA_PK4(P, BASE, OUT) do { unsigned a0 = cvtpk(P[BASE + 0], P[BASE + 1]), a1 = cvtpk(P[BASE + 2], P[BASE + 3]);   \
    unsigned b0 = cvtpk(P[BASE + 4], P[BASE + 5]), b1 = cvtpk(P[BASE + 6], P[BASE + 7]);                              \
    auto r0 = __builtin_amdgcn_permlane32_swap(a0, b0, false, false); auto r1 = __builtin_amdgcn_permlane32_swap(a1, b1, false, false); \
    u32x4 w = {r0[0], r1[0], r0[1], r1[1]}; OUT = *reinterpret_cast<bf16x8*>(&w); } while (0)
  DA_PK4(p0, 0, pa0); DA_PK4(p0, 8, pa1); DA_PK4(p1, 0, pa2); DA_PK4(p1, 8, pa3);
#undef DA_PK4
}
__device__ __forceinline__ void qkt(f32x16& p0, f32x16& p1, const char* Ks, const bf16x8* qr, int r32, int hi, const f32x16& negoff) {
  p0 = negoff; p1 = negoff;
#pragma unroll
  for (int d0 = 0; d0 < 4; ++d0) { const int cb = (d0 * 16 + hi * 8) * 2;
    bf16x8 b0 = *reinterpret_cast<const bf16x8*>(Ks + DA_KSWZ(r32, cb));
    bf16x8 b1 = *reinterpret_cast<const bf16x8*>(Ks + DA_KSWZ(32 + r32, cb));
    p0 = __builtin_amdgcn_mfma_f32_32x32x16_bf16(b0, qr[d0], p0, 0, 0, 0);
    p1 = __builtin_amdgcn_mfma_f32_32x32x16_bf16(b1, qr[d0], p1, 0, 0, 0); }
}
__device__ __forceinline__ int v_st(int k, int c) { const int kk = (k & ~0xC) | ((k & 4) << 1) | ((k & 8) >> 1); return ((kk >> 3) * 4 + (c >> 5)) * 512 + ((kk & 7) * 32 + (c & 31)) * 2; }
__device__ __forceinline__ int v_rd_base(int lane) { return ((lane & 3) << 3) | (((lane >> 2) & 3) << 6) | (((lane >> 4) & 1) << 5) | (((lane >> 5) & 1) << 8); }
constexpr int v_rd_off(int d0, int ks, int half) { return d0 * 512 + ks * 4096 + half * 2048; }
template <int OFF> __device__ __forceinline__ s16x4 tr_read(int vb) { s16x4 r; asm volatile("ds_read_b64_tr_b16 %0, %1 offset:%2" : "=&v"(r) : "v"(vb), "i"(OFF) : "memory"); return r; }
template <int D0> __device__ __forceinline__ void pv_one(f32x16& od, int vb, bf16x8 pa0, bf16x8 pa1, bf16x8 pa2, bf16x8 pa3) {
  const s16x4 l0 = tr_read<v_rd_off(D0, 0, 0)>(vb), h0 = tr_read<v_rd_off(D0, 0, 1)>(vb), l1 = tr_read<v_rd_off(D0, 1, 0)>(vb), h1 = tr_read<v_rd_off(D0, 1, 1)>(vb);
  const s16x4 l2 = tr_read<v_rd_off(D0, 2, 0)>(vb), h2 = tr_read<v_rd_off(D0, 2, 1)>(vb), l3 = tr_read<v_rd_off(D0, 3, 0)>(vb), h3 = tr_read<v_rd_off(D0, 3, 1)>(vb);
  asm volatile("s_waitcnt lgkmcnt(0)" ::: "memory"); DA_SBAR();
#define DA_PK(L, H) (bf16x8){L[0], L[1], L[2], L[3], H[0], H[1], H[2], H[3]}
  od = __builtin_amdgcn_mfma_f32_32x32x16_bf16(pa0, DA_PK(l0, h0), od, 0, 0, 0);
  od = __builtin_amdgcn_mfma_f32_32x32x16_bf16(pa1, DA_PK(l1, h1), od, 0, 0, 0);
  od = __builtin_amdgcn_mfma_f32_32x32x16_bf16(pa2, DA_PK(l2, h2), od, 0, 0, 0);
  od = __builtin_amdgcn_mfma_f32_32x32x16_bf16(pa3, DA_PK(l3, h3), od, 0, 0, 0);
#undef DA_PK
}
__device__ __forceinline__ void pv_d0(f32x16* o, int vb, bf16x8 pa0, bf16x8 pa1, bf16x8 pa2, bf16x8 pa3) {
  pv_one<0>(o[0], vb, pa0, pa1, pa2, pa3); pv_one<1>(o[1], vb, pa0, pa1, pa2, pa3); pv_one<2>(o[2], vb, pa0, pa1, pa2, pa3); pv_one<3>(o[3], vb, pa0, pa1, pa2, pa3);
}
__device__ __forceinline__ void flash_pass(const bf16r* __restrict__ Qb, const bf16r* __restrict__ Kh, const bf16r* __restrict__ Vh, char* lds, int tid, float off, f32x16 (&o)[4], float& l_reg) {
  tid = opqv(tid);
  const int wid = __builtin_amdgcn_readfirstlane(tid >> 6), lane = tid & 63, r32 = lane & 31, hi = lane >> 5;
  char* V_lds = lds; char* K_lds = lds + OFF_K;
  l_reg = 0.f; f32x16 negoff;
#pragma unroll
  for (int r = 0; r < 16; ++r) negoff[r] = -off;
  asm volatile("" : "+v"(negoff));
#pragma unroll
  for (int d = 0; d < 4; ++d) o[d] = f32x16{};
  bf16x8 qr[4];
  const bf16r* Qw = Qb + (long)(wid * QBLK + r32) * DQK + hi * 8;
#pragma unroll
  for (int d0 = 0; d0 < 4; ++d0) qr[d0] = *reinterpret_cast<const bf16x8*>(Qw + d0 * 16);
  const int sr = tid >> 4, sc = (tid & 15) * 8, vst0 = v_st(sr, sc), vst1 = v_st(32 + sr, sc);
  const int kr = tid >> 3, kc = (tid & 7) * 8, kst = DA_KSWZ(kr, kc * 2);
  const int vb0 = (int)(uintptr_t)V_lds + v_rd_base(lane);
  struct { bf16x8 vs0, vs1, ks; } sr_[2];
#define DA_SLOAD(i, k0) do { sr_[i].vs0 = *reinterpret_cast<const bf16x8*>(&Vh[(long)((k0) + sr) * DV + sc]); sr_[i].vs1 = *reinterpret_cast<const bf16x8*>(&Vh[(long)((k0) + 32 + sr) * DV + sc]); \
    sr_[i].ks = *reinterpret_cast<const bf16x8*>(&Kh[(long)((k0) + kr) * DQK + kc]); } while (0)
#define DA_SWRITE(b, i) do { *(bf16x8*)(V_lds + (b) * SHM_V + vst0) = sr_[i].vs0; *(bf16x8*)(V_lds + (b) * SHM_V + vst1) = sr_[i].vs1; *(bf16x8*)(K_lds + (b) * SHM_K + kst) = sr_[i].ks; } while (0)
#define DA_SWAIT() asm volatile("s_waitcnt vmcnt(3)" ::: "memory")
  f32x16 pA0, pA1, pB0, pB1; bf16x8 pa0, pa1, pa2, pa3; constexpr int NT = SEQ / KVBLK;
  constexpr int SE = 0, SO = 1;
  DA_SLOAD(SE, 0); asm volatile("s_waitcnt vmcnt(0)" ::: "memory"); DA_SWRITE(0, SE); __syncthreads();
  qkt(pA0, pA1, K_lds, qr, r32, hi, negoff); partialSM(pA0);
  DA_SLOAD(SO, KVBLK); DA_SLOAD(SE, 2 * KVBLK);
  DA_SWAIT(); DA_SWRITE(1, SO); __syncthreads();
  for (int j = 1; j + 1 < NT; j += 2) {
    DA_SBAR(); qkt(pB0, pB1, K_lds + SHM_K, qr, r32, hi, negoff);
    finishSM(pA0, pA1, l_reg, pa0, pa1, pa2, pa3); DA_SBAR();
    DA_SLOAD(SO, (j + 2) * KVBLK); DA_SBAR();
    pv_d0(o, vb0, pa0, pa1, pa2, pa3); partialSM(pB0);
    __syncthreads(); DA_SWAIT(); DA_SWRITE(0, SE);
    __syncthreads();
    DA_SBAR(); qkt(pA0, pA1, K_lds, qr, r32, hi, negoff);
    finishSM(pB0, pB1, l_reg, pa0, pa1, pa2, pa3); DA_SBAR();
    if (j + 3 < NT) DA_SLOAD(SE, (j + 3) * KVBLK); DA_SBAR();
    pv_d0(o, vb0 + SHM_V, pa0, pa1, pa2, pa3); partialSM(pA0);
    __syncthreads(); DA_SWAIT(); DA_SWRITE(1, SO);
    __syncthreads();
  }
  DA_SBAR(); qkt(pB0, pB1, K_lds + SHM_K, qr, r32, hi, negoff);
  finishSM(pA0, pA1, l_reg, pa0, pa1, pa2, pa3); DA_SBAR();
  pv_d0(o, vb0, pa0, pa1, pa2, pa3); partialSM(pB0);
  __syncthreads();
  finishSM(pB0, pB1, l_reg, pa0, pa1, pa2, pa3); DA_SBAR();
  pv_d0(o, vb0 + SHM_V, pa0, pa1, pa2, pa3);
#undef DA_SLOAD
#undef DA_SWRITE
#undef DA_SWAIT
}
__device__ __forceinline__ void diff_unit(const bf16r* Qt, const bf16r* Kt, const bf16r* Vt, bf16r* OB, int b, int h8, int q0, float lam, const float* sub_g, float osc, float eps, float off, char* lds, int tid) {
  const int wid = __builtin_amdgcn_readfirstlane(tid >> 6), lane = tid & 63;
  float* ws = (float*)(lds + OFF_WS) + wid * 64; float* li_l = ws;
  char* stash = lds + OFF_STASH + wid * (QBLK * DV * 2);
  f32x16 o[4]; float l_reg;
  const bf16r* Vh = Vt + ((long)(b * 8 + h8) * SEQ) * DV;
  flash_pass(Qt + ((long)(b * 16 + 2 * h8) * SEQ + q0) * DQK, Kt + ((long)(b * 16 + 2 * h8) * SEQ) * DQK, Vh, lds, tid, off, o, l_reg);
  { const int lane_ = opqv(lane), r32 = lane_ & 31, hi = lane_ >> 5;
    if (hi == 0) li_l[r32] = l_reg; asm volatile("s_waitcnt lgkmcnt(0)" ::: "memory");
#pragma unroll
    for (int r = 0; r < 16; ++r) { const int q = crow(r, hi); const float rl = __builtin_amdgcn_rcpf(li_l[q]);
#pragma unroll
      for (int d0 = 0; d0 < 4; ++d0) *(bf16r*)(stash + (q * DV + d0 * 32 + r32) * 2) = (bf16r)(cvtpk(o[d0][r] * rl, 0.f) & 0xffffu); } }
  asm volatile("s_waitcnt lgkmcnt(0)" ::: "memory");
  flash_pass(Qt + ((long)(b * 16 + 2 * h8 + 1) * SEQ + q0) * DQK, Kt + ((long)(b * 16 + 2 * h8 + 1) * SEQ) * DQK, Vh, lds, tid, off, o, l_reg);
  { const int lane_ = opqv(lane), r32 = lane_ & 31, hi = lane_ >> 5;
    if (hi == 0) li_l[r32] = l_reg; asm volatile("s_waitcnt lgkmcnt(0)" ::: "memory");
    float sg[4];
#pragma unroll
    for (int d0 = 0; d0 < 4; ++d0) sg[d0] = sub_g[d0 * 32 + r32] * osc;
#pragma unroll
    for (int r = 0; r < 16; ++r) { const int q = crow(r, hi); const float rl = __builtin_amdgcn_rcpf(li_l[q]) * lam; float od[4]; float ss = 0.f;
#pragma unroll
      for (int d0 = 0; d0 < 4; ++d0) { const unsigned s0 = *(const bf16r*)(stash + (q * DV + d0 * 32 + r32) * 2); od[d0] = __uint_as_float(s0 << 16) - o[d0][r] * rl; ss += od[d0] * od[d0]; }
#pragma unroll
      for (int x = 1; x < 32; x <<= 1) ss += __shfl_xor(ss, x);
      const float rstd = 1.0f / sqrtf(ss * (1.f / DV) + eps);
#pragma unroll
      for (int d0 = 0; d0 < 4; ++d0) *(bf16r*)(stash + (q * DV + d0 * 32 + r32) * 2) = (bf16r)(cvtpk(od[d0] * rstd * sg[d0], 0.f) & 0xffffu); }
    asm volatile("s_waitcnt lgkmcnt(0)" ::: "memory");
    bf16r* Ow = OB + ((long)(b * SEQ + q0 + wid * QBLK)) * 1024 + h8 * DV;
#pragma unroll
    for (int i = 0; i < 8; ++i) { const int row = (lane_ >> 4) + 4 * i, ch = lane_ & 15;
      const u32x4 w = *(const u32x4*)(stash + row * (DV * 2) + ch * 16); *(u32x4*)(Ow + (long)row * 1024 + ch * 8) = w; } }
  asm volatile("s_waitcnt lgkmcnt(0)" ::: "memory");
}
#undef DA_KSWZ
#undef DA_SBAR
}
constexpr int NWAVES = 8;
constexpr int BATCH = 16, SEQ = 2048, D = 1024, M = BATCH * SEQ, NH = 16, HD = 64, NE = 16, CAP = 256, DFF = 2048, NSLOT = BATCH * NE * CAP, NLAYER = 4;
constexpr float EPS = 1e-6f;
constexpr int N_IN = 28;
enum { I_X = 0, I_GMIX, I_GFFN, I_NA_WQKV, I_NA_QN, I_NA_KN, I_NA_RPB, I_NA_WOUT, I_DF_WQKV, I_DF_QN, I_DF_KN, I_DF_LQ1, I_DF_LK1, I_DF_LQ2, I_DF_LK2, I_DF_SUB, I_DF_WOUT,
       I_SC_WIN, I_SC_CONV, I_SC_WOUT, I_DL_WQKV, I_DL_QN, I_DL_KN, I_DL_WOUT, I_ROUTER, I_WGATE, I_WUP, I_WDOWN };
constexpr size_t MiB = 1u << 20;
constexpr size_t WS_CTL = 0, CTL_ZERO_BYTES = 1 * MiB;
constexpr size_t WS_AFFT = 2 * MiB;
constexpr size_t WS_IDX = 4 * MiB;
constexpr size_t WS_GATE = 4 * MiB + 512 * 1024;
constexpr size_t WS_SLOTOF = 6 * MiB;
constexpr size_t WS_LSE = 8 * MiB;
constexpr size_t WS_ROPE = 15 * MiB;
constexpr size_t WS_WQKV = 16 * MiB;
constexpr size_t WS_WOUT = 52 * MiB;
constexpr size_t WS_WGU = 64 * MiB;
constexpr size_t WS_WDN = 576 * MiB;
constexpr size_t WS_HN8 = 704 * MiB;
constexpr size_t WS_HN = 832 * MiB;
constexpr size_t WS_QKV = 896 * MiB;
constexpr size_t WS_XIN = 896 * MiB;
constexpr size_t WS_HMID = 1024 * MiB;
constexpr size_t WS_Y = 1280 * MiB;
constexpr size_t WS_O = 1472 * MiB;
constexpr size_t WS_OG = 1536 * MiB;
constexpr size_t WS_MIX = WS_OG;
constexpr size_t WS_XB = 1792 * MiB;
constexpr size_t WS_END = 1856 * MiB;
__host__ __device__ constexpr size_t wqkv_off(int L) { return WS_WQKV + (size_t)L * 6 * MiB; }
constexpr int CW_TMO = 0, CW_CODE = 1, CW_BAR = 4096;
constexpr int RING_OFF = 0, RING_BYTES = 131072;
constexpr int LDSCTL_OFF = RING_BYTES, MISC_OFF = LDSCTL_OFF + 320;
constexpr int LDS_BYTES = 147456;

struct Args { const float* in[N_IN]; float* out; unsigned char* ws; int ph_lo, ph_hi, li, pad; };
struct Frame {
    LAS unsigned char* lds;
    volatile LAS unsigned* MISC;
    gu32* ctl;
    int tid, lane, wave, vcu, G, gw, NGW;
    float* out; unsigned char* ws;
};
__device__ __forceinline__ int opq(int v) { asm volatile("" : "+v"(v)); return v; }
__device__ __forceinline__ int opq_s(int v) { asm volatile("" : "+s"(v)); return v; }
__device__ __forceinline__ Frame make_frame(const Args& args, unsigned char* lds_generic, int wave_s) {
    Frame F;
    F.lds = (LAS unsigned char*)lds_generic;
    F.MISC = (volatile LAS unsigned*)(F.lds + MISC_OFF);
    F.wave = opq_s(wave_s); F.lane = opq((int)__builtin_amdgcn_mbcnt_hi(~0u, __builtin_amdgcn_mbcnt_lo(~0u, 0u))); F.tid = F.wave * 64 + F.lane;
    F.G = opq_s((int)gridDim.x); { const int bx = opq_s((int)blockIdx.x); F.vcu = (F.G % 8 == 0) ? (bx % 8) * (F.G / 8) + bx / 8 : bx; }
    F.gw = F.vcu * NWAVES + F.wave; F.NGW = F.G * NWAVES;
    F.out = args.out; F.ws = args.ws;
    F.ctl = (gu32*)(args.ws + WS_CTL);
    return F;
}
__device__ __forceinline__ XcdBarrier make_bar(const Args& args, unsigned char* lds_generic) {
    XcdBarrier b; b.bar = (unsigned*)((gu32*)(args.ws + WS_CTL) + CW_BAR) + args.li * XCD_BAR_WORDS; b.x = xb_xcc_id(); b.st = (volatile LAS unsigned*)((LAS unsigned char*)lds_generic + MISC_OFF) + 8; return b;
}
__device__ __forceinline__ float wave_sum(float v) {
#pragma unroll
    for (int o = 1; o < 64; o <<= 1) v += __shfl_xor(v, o);
    return v;
}
__device__ __forceinline__ float bflo(unsigned u) { return __uint_as_float(u << 16); }
__device__ __forceinline__ float bfhi(unsigned u) { return __uint_as_float(u & 0xffff0000u); }
__device__ __forceinline__ void unpack8(const v4u w, float (&x)[8]) { x[0] = bflo(w.x); x[1] = bfhi(w.x); x[2] = bflo(w.y); x[3] = bfhi(w.y); x[4] = bflo(w.z); x[5] = bfhi(w.z); x[6] = bflo(w.w); x[7] = bfhi(w.w); }
__device__ __forceinline__ v4u pack8(const float (&x)[8]) { v4u w; w.x = pk2(x[0], x[1]); w.y = pk2(x[2], x[3]); w.z = pk2(x[4], x[5]); w.w = pk2(x[6], x[7]); return w; }

template <bool F32> struct XRow;
template <> struct XRow<true> { f32x4 r[4];
    __device__ __forceinline__ void load(const void* base, int m, int lane) { const GAS f32x4* xr = (const GAS f32x4*)((const float*)base + (size_t)m * D) + lane;
#pragma unroll
        for (int j = 0; j < 4; ++j) r[j] = xr[64 * j]; }
    __device__ __forceinline__ void get(f32x4 (&v)[4]) const {
#pragma unroll
        for (int j = 0; j < 4; ++j) v[j] = r[j]; } };
template <> struct XRow<false> { unsigned long long r[4];
    __device__ __forceinline__ void load(const void* base, int m, int lane) { const GAS unsigned long long* xr = (const GAS unsigned long long*)((const bf16*)base + (size_t)m * D) + lane;
#pragma unroll
        for (int j = 0; j < 4; ++j) r[j] = xr[64 * j]; }
    __device__ __forceinline__ void get(f32x4 (&v)[4]) const {
#pragma unroll
        for (int j = 0; j < 4; ++j) { const unsigned lo_ = (unsigned)r[j], hi_ = (unsigned)(r[j] >> 32); v[j] = (f32x4){bflo(lo_), bfhi(lo_), bflo(hi_), bfhi(hi_)}; } } };
__device__ __forceinline__ void add_bf16_row(f32x4 (&v)[4], const unsigned long long (&mv)[4]) {
#pragma unroll
    for (int j = 0; j < 4; ++j) { const unsigned lo_ = (unsigned)mv[j], hi_ = (unsigned)(mv[j] >> 32); v[j].x += bflo(lo_); v[j].y += bfhi(lo_); v[j].z += bflo(hi_); v[j].w += bfhi(hi_); }
}
__device__ __forceinline__ void tr_item(const float* srcl, size_t ldn, int k0, bf16* WT, int K, int drow0, LAS float* scr, int lane) {
#pragma unroll 8
    for (int i = 0; i < 32; ++i) { const int kk = 2 * i + (lane >> 5); scr[kk * 33 + (lane & 31)] = srcl[(size_t)(k0 + kk) * ldn]; }
    LDS_WAIT(); asm volatile("" ::: "memory");
    const int c = lane & 7;
#pragma unroll
    for (int j = 0; j < 4; ++j) { const int n = (lane >> 3) + 8 * j; const LAS float* s = scr + (8 * c) * 33 + n;
        v4u o; o.x = pk2(s[0 * 33], s[1 * 33]); o.y = pk2(s[2 * 33], s[3 * 33]); o.z = pk2(s[4 * 33], s[5 * 33]); o.w = pk2(s[6 * 33], s[7 * 33]);
        *(GAS v4u*)(WT + (size_t)(drow0 + n) * K + k0 + 8 * c) = o; }
    LDS_WAIT(); asm volatile("" ::: "memory");
}
typedef unsigned v2u __attribute__((ext_vector_type(2)));
__device__ __forceinline__ void tr_item8(const float* srcl, size_t ldn, int k0, unsigned char* WT, int K, int drow0, float sc, LAS float* scr, int lane) {
#pragma unroll 8
    for (int i = 0; i < 32; ++i) { const int kk = 2 * i + (lane >> 5); scr[kk * 33 + (lane & 31)] = srcl[(size_t)(k0 + kk) * ldn]; }
    LDS_WAIT(); asm volatile("" ::: "memory");
    const int c = lane & 7;
#pragma unroll
    for (int j = 0; j < 4; ++j) { const int n = (lane >> 3) + 8 * j; const LAS float* s = scr + (8 * c) * 33 + n;
        v2u o; o.x = pg8::pk4_fp8(s[0 * 33] * sc, s[1 * 33] * sc, s[2 * 33] * sc, s[3 * 33] * sc); o.y = pg8::pk4_fp8(s[4 * 33] * sc, s[5 * 33] * sc, s[6 * 33] * sc, s[7 * 33] * sc);
        *(GAS v2u*)(WT + (size_t)(drow0 + n) * K + k0 + 8 * c) = o; }
    LDS_WAIT(); asm volatile("" ::: "memory");
}
struct CvtDesc { const float* srcl; unsigned char* WT; size_t ldn; int k0, K, drow0, prow; };
__device__ __forceinline__ void cvt8_load(const CvtDesc& d, f32x4 (&v)[16], int lane) {
    const int r = lane >> 3;
#pragma unroll
    for (int i = 0; i < 4; ++i)
#pragma unroll
        for (int j = 0; j < 4; ++j) v[4 * i + j] = *(const GAS f32x4*)(d.srcl + (size_t)(d.k0 + 32 * i + 4 * r + j) * d.ldn);
}
__device__ __forceinline__ void cvt8_finish(const CvtDesc& d, const f32x4 (&v)[16], float sc, LAS unsigned char* scr, int lane) {
    const int r = lane >> 3;
#pragma unroll
    for (int i = 0; i < 4; ++i)
#pragma unroll
        for (int e = 0; e < 4; ++e)
            *(LAS unsigned*)(scr + (d.prow + e) * 144 + 32 * i + 4 * r) = pg8::pk4_fp8(v[4 * i][e] * sc, v[4 * i + 1][e] * sc, v[4 * i + 2][e] * sc, v[4 * i + 3][e] * sc);
    LDS_WAIT(); asm volatile("" ::: "memory");
#pragma unroll
    for (int q = 0; q < 4; ++q) { const int row = r + 8 * q, ch = lane & 7;
        const v4u w = *(const LAS v4u*)(scr + row * 144 + ch * 16);
        *(GAS v4u*)(d.WT + (size_t)(d.drow0 + row) * d.K + d.k0 + ch * 16) = w; }
    LDS_WAIT(); asm volatile("" ::: "memory");
}
__device__ __forceinline__ void cvtb_load(const CvtDesc& d, f32x4 (&v)[16], int wave) {
#pragma unroll
    for (int a = 0; a < 4; ++a)
#pragma unroll
        for (int j = 0; j < 4; ++j) v[4 * a + j] = *(const GAS f32x4*)(d.srcl + (size_t)(d.k0 + 16 * wave + 4 * a + j) * d.ldn);
}
__device__ __forceinline__ void cvtb_pack(const CvtDesc& d, const f32x4 (&v)[16], float sc, LAS unsigned char* tile, int wave) {
#pragma unroll
    for (int a = 0; a < 4; ++a)
#pragma unroll
        for (int e = 0; e < 4; ++e)
            *(LAS unsigned*)(tile + (d.prow + e) * 132 + 16 * wave + 4 * a) = pg8::pk4_fp8(v[4 * a][e] * sc, v[4 * a + 1][e] * sc, v[4 * a + 2][e] * sc, v[4 * a + 3][e] * sc);
}
__device__ __forceinline__ void cvtb_out(const CvtDesc& d, LAS const unsigned char* tile, int wave, int lane) {
#pragma unroll
    for (int q = 0; q < 4; ++q) { const int row = 32 * wave + (lane >> 3) + 8 * q, ch = lane & 7; const LAS unsigned* s = (const LAS unsigned*)(tile + row * 132 + ch * 16);
        v4u w; w.x = s[0]; w.y = s[1]; w.z = s[2]; w.w = s[3];
        *(GAS v4u*)(d.WT + (size_t)(d.drow0 + row) * d.K + d.k0 + ch * 16) = w; }
}
__device__ __forceinline__ void cvtb_pack16(const CvtDesc& d, const f32x4 (&v)[16], LAS unsigned char* tile, int wave) {
#pragma unroll
    for (int a = 0; a < 4; ++a)
#pragma unroll
        for (int e = 0; e < 4; ++e) { LAS unsigned* p = (LAS unsigned*)(tile + (d.prow + e) * 260 + (16 * wave + 4 * a) * 2);
            p[0] = pk2(v[4 * a][e], v[4 * a + 1][e]); p[1] = pk2(v[4 * a + 2][e], v[4 * a + 3][e]); }
}
__device__ __forceinline__ void cvtb_out16(const CvtDesc& d, LAS const unsigned char* tile, int wave, int lane) {
#pragma unroll
    for (int q = 0; q < 8; ++q) { const int row = 32 * wave + (lane >> 4) + 4 * q, ch = lane & 15; const LAS unsigned* s = (const LAS unsigned*)(tile + row * 260 + ch * 16);
        v4u w; w.x = s[0]; w.y = s[1]; w.z = s[2]; w.w = s[3];
        *(GAS v4u*)(d.WT + ((size_t)(d.drow0 + row) * d.K + d.k0) * 2 + ch * 16) = w; }
}
__device__ __forceinline__ void tr_plain(const float* W, int K, int N, bf16* WT, int item, LAS float* scr, int lane) {
    const int nblk = N / 32, kb = item / nblk, nb = item % nblk;
    tr_item(W + 32 * nb + (lane & 31), (size_t)N, 64 * kb, WT, K, 32 * nb, scr, lane);
}
__device__ __forceinline__ void tr_qkv(const float* W, int K, int N, bf16* WT, int item, LAS float* scr, int lane) {
    const int nblk = N / 32, kb = item / nblk, nb = item % nblk, n0 = 32 * nb;
    tr_item(W + n0 + (lane & 31), (size_t)N, 64 * kb, WT, K, (n0 & ~255) + 128 * ((n0 >> 5) & 1) + 32 * ((n0 >> 6) & 3), scr, lane);
}
__device__ __forceinline__ void rms_apply(f32x4 (&v)[4], const f32x4 (&gg)[4]) {
    float s = 0.f;
#pragma unroll
    for (int j = 0; j < 4; ++j) s += (v[j].x * v[j].x + v[j].y * v[j].y) + (v[j].z * v[j].z + v[j].w * v[j].w);
    const float rstd = 1.0f / sqrtf(wave_sum(s) * (1.f / D) + EPS);
#pragma unroll
    for (int j = 0; j < 4; ++j) v[j] = v[j] * rstd * gg[j];
}
__device__ __forceinline__ void store_row_bf16(bf16* orow, int lane, const f32x4 (&v)[4]) {
    GAS unsigned long long* o8 = (GAS unsigned long long*)orow + lane;
#pragma unroll
    for (int j = 0; j < 4; ++j) o8[64 * j] = (unsigned long long)pk2(v[j].x, v[j].y) | ((unsigned long long)pk2(v[j].z, v[j].w) << 32);
}
__device__ __forceinline__ void p0_prologue(Frame& F, const Args& A) {
    LAS float* scr = (LAS float*)(F.lds + RING_OFF + F.wave * 16384);
    const float* wgate = A.in[I_WGATE]; const float* wup = A.in[I_WUP]; const float* wdown = A.in[I_WDOWN];
    unsigned char* WGU = (unsigned char*)(F.ws + WS_WGU); unsigned char* WDN = (unsigned char*)(F.ws + WS_WDN);
    constexpr int B_GU = 64 * 128, B_DN = 64 * 64, B_Q3 = 8 * 36, B_O3 = 8 * 4, NB8 = B_GU + B_DN + B_Q3 + B_O3;
    const int lane = F.lane, wave = F.wave;
    const float* wqkv3 = A.in[I_DL_WQKV]; unsigned char* WQ3 = (unsigned char*)(F.ws + wqkv_off(3)); const float* wout3 = A.in[I_DL_WOUT]; unsigned char* WO3 = (unsigned char*)(F.ws + WS_WOUT + 3 * 2 * MiB);
    LAS unsigned char* tile = (LAS unsigned char*)(F.lds + RING_OFF);
#define CVT_DECODE(IT, DD) do { int r_ = (IT); \
        if (r_ < B_GU) { const int le = r_ >> 7, rr = r_ & 127, kb = rr >> 4, nb = rr & 15, n0 = 256 * nb, up_ = lane >> 5, l_ = lane & 31;     \
            DD.srcl = (up_ ? wup : wgate) + (size_t)le * (1024 * 2048) + (n0 >> 1) + 4 * l_; DD.ldn = 2048; DD.k0 = 128 * kb; DD.WT = WGU + (size_t)le * (4096 * 1024); DD.K = 1024; DD.drow0 = n0; DD.prow = 4 * l_ + 128 * up_; } \
        else if (r_ < B_GU + B_DN) { r_ -= B_GU; const int le = r_ >> 6, rr = r_ & 63, kb = rr >> 2, nb = rr & 3;                                \
            DD.srcl = wdown + (size_t)le * (2048 * 1024) + 256 * nb + 4 * lane; DD.ldn = 1024; DD.k0 = 128 * kb; DD.WT = WDN + (size_t)le * (1024 * 2048); DD.K = 2048; DD.drow0 = 256 * nb; DD.prow = 4 * lane; } \
        else if (r_ < B_GU + B_DN + B_Q3) { r_ -= B_GU + B_DN; const int kb = r_ / 36, nb = r_ % 36, hw_ = lane >> 4, bj_ = (lane >> 3) & 1, j4_ = lane & 7;     \
            DD.srcl = wqkv3 + 256 * nb + 4 * lane; DD.ldn = 9216; DD.k0 = 128 * kb; DD.WT = WQ3; DD.K = 1024; DD.drow0 = 256 * nb; DD.prow = 128 * bj_ + 32 * hw_ + 4 * j4_; } \
        else { r_ -= B_GU + B_DN + B_Q3; const int kb = r_ >> 2, nb = r_ & 3;                                                                      \
            DD.srcl = wout3 + 256 * nb + 4 * lane; DD.ldn = 1024; DD.k0 = 128 * kb; DD.WT = WO3; DD.K = 1024; DD.drow0 = 256 * nb; DD.prow = 4 * lane; } } while (0)
    { CvtDesc dA, dB; f32x4 vA[16], vB[16]; int it = F.vcu;
      if (it < NB8) { CVT_DECODE(it, dA); cvtb_load(dA, vA, wave); }
      while (it < NB8) {
          const int i1 = it + F.G, i2 = it + 2 * F.G;
          if (i1 < NB8) { CVT_DECODE(i1, dB); cvtb_load(dB, vB, wave); }
          cvtb_pack(dA, vA, 256.f, tile, wave); __syncthreads(); cvtb_out(dA, tile, wave, lane); __syncthreads();
          if (i1 >= NB8) break;
          if (i2 < NB8) { CVT_DECODE(i2, dA); cvtb_load(dA, vA, wave); }
          cvtb_pack(dB, vB, 256.f, tile, wave); __syncthreads(); cvtb_out(dB, tile, wave, lane); __syncthreads();
          it = i2; } }
#undef CVT_DECODE
    { constexpr int B_Q = 8 * 12, B_O = 8 * 4, NB16 = 3 * B_Q + 3 * B_O;
      for (int it = F.vcu; it < NB16; it += F.G) { CvtDesc dd; f32x4 vv[16]; int r_ = it;
          if (r_ < 3 * B_Q) { const int which = r_ / B_Q, rr = r_ % B_Q, kb = rr / 12, nb = rr % 12, hw_ = lane >> 4, bj_ = (lane >> 3) & 1, j4_ = lane & 7;
              const float* W = (which == 0) ? A.in[I_NA_WQKV] : (which == 1) ? A.in[I_DF_WQKV] : A.in[I_SC_WIN];
              dd.srcl = W + 256 * nb + 4 * lane; dd.ldn = 3072; dd.k0 = 128 * kb; dd.WT = (unsigned char*)(F.ws + wqkv_off(which)); dd.K = 1024; dd.drow0 = 256 * nb; dd.prow = 128 * bj_ + 32 * hw_ + 4 * j4_; }
          else { r_ -= 3 * B_Q; const int which = r_ / B_O, rr = r_ % B_O, kb = rr >> 2, nb = rr & 3;
              const float* W = (which == 0) ? A.in[I_NA_WOUT] : (which == 1) ? A.in[I_DF_WOUT] : A.in[I_SC_WOUT];
              dd.srcl = W + 256 * nb + 4 * lane; dd.ldn = 1024; dd.k0 = 128 * kb; dd.WT = (unsigned char*)(F.ws + WS_WOUT + (size_t)which * 2 * MiB); dd.K = 1024; dd.drow0 = 256 * nb; dd.prow = 4 * lane; }
          cvtb_load(dd, vv, wave); cvtb_pack16(dd, vv, tile, wave); __syncthreads(); cvtb_out16(dd, tile, wave, lane); __syncthreads(); } }
    { float2* rope = (float2*)(F.ws + WS_ROPE);
      for (int idx = blockIdx.x * (NWAVES * 64) + opq(F.tid); idx < SEQ * 32; idx += F.G * NWAVES * 64) { const int pos = idx >> 5, j = idx & 31;
          const float invf = exp2f(-(float)j * 0.41524101186092029f); const float af = (float)pos * invf;
          const double a = (double)af; const double n = rint(a * 0.15915494309189535); const float rf = (float)(a - n * 6.283185307179586);
          rope[idx] = make_float2(__cosf(rf), __sinf(rf)); } }
    { const float* g = A.in[I_GMIX]; f32x4 gg[4];
#pragma unroll
      for (int j = 0; j < 4; ++j) gg[j] = ((const GAS f32x4*)g)[lane + 64 * j];
      bf16* HN = (bf16*)(F.ws + WS_HN); const float* x = A.in[I_X];
      XRow<true> xc, xn; xc.load(x, F.gw, lane);
      for (int m = F.gw; m < M; m += F.NGW) { const int mn = (m + F.NGW < M) ? m + F.NGW : m; xn.load(x, mn, lane);
          f32x4 v[4]; xc.get(v); rms_apply(v, gg); store_row_bf16(HN + (size_t)m * D, lane, v); xc = xn; } }
}

__device__ __forceinline__ void prep_phase(Frame& F, bf16* buf, int ld, int ng, const float* qg, const float* kg, bool use_rope, float qscale) {
    const int lane = opq(F.lane), c = lane & 7, nch = 4 * ng; const long total = (long)M * nch;
    const float2* rope = (const float2*)(F.ws + WS_ROPE);
    float gq[8], gk[8];
#pragma unroll
    for (int i = 0; i < 8; ++i) { gq[i] = qg[c * 8 + i]; gk[i] = kg[c * 8 + i]; }
    for (long it = F.gw; it < total; it += F.NGW) {
        const int tok = (int)(it / nch), ch = (int)(it % nch), g = ch >> 2, part = (ch >> 1) & 1, half = ch & 1;
        bf16* p = buf + (size_t)tok * ld + g * 3072 + part * 1024 + half * 512 + lane * 8;
        const v4u w = *(const GAS v4u*)p; float x[8]; unpack8(w, x);
        float ss = 0.f;
#pragma unroll
        for (int i = 0; i < 8; ++i) ss += x[i] * x[i];
        ss += __shfl_xor(ss, 1); ss += __shfl_xor(ss, 2); ss += __shfl_xor(ss, 4);
        const float rstd = 1.0f / sqrtf(ss * (1.f / 64.f) + EPS);
        float y[8];
#pragma unroll
        for (int i = 0; i < 8; ++i) y[i] = x[i] * rstd * (part ? gk[i] : gq[i]);
        if (use_rope) { const int pos = tok & (SEQ - 1); const float2* rp = rope + pos * 32 + 8 * (c & 3);
#pragma unroll
            for (int i = 0; i < 8; ++i) { const float py = __shfl_xor(y[i], 4); const float2 cs = rp[i];
                y[i] = (c < 4) ? (y[i] * cs.x - py * cs.y) : (y[i] * cs.x + py * cs.y); } }
        if (part == 0) {
#pragma unroll
            for (int i = 0; i < 8; ++i) y[i] *= qscale; }
        *(GAS v4u*)p = pack8(y);
    }
}

__device__ __forceinline__ void diff_attn_phase(Frame& F, const bf16* QKV, bf16* OC, char* lds_generic) {
    for (int i = 0;; ++i) { const int Lu = i * F.G + F.vcu; if (Lu >= BATCH * 32 * 8) break;
        const int qb = Lu & 7, hp = (Lu >> 3) & 31, b = Lu >> 8, h8 = hp >> 2, c = (hp >> 1) & 1, vh = hp & 1;
        constexpr size_t TEN = (size_t)32 << 20;
        attn_body::attn_unit<8>((const attn_body::bf16*)(QKV + ((size_t)(b * 16 + 2 * h8 + c) * SEQ) * 64), (const attn_body::bf16*)(QKV + TEN + ((size_t)(b * 16 + 2 * h8 + c) * SEQ) * 64),
                                (const attn_body::bf16*)(QKV + 2 * TEN + ((size_t)(b * 8 + h8) * SEQ) * 128 + vh * 64),
                                (attn_body::bf16*)(OC + ((size_t)c * M + (size_t)b * SEQ) * D + h8 * 128 + vh * 64), qb * 256, lds_generic, F.tid); }
}
__device__ __forceinline__ void diff_combine(Frame& F, const Args& A, const bf16* OC, bf16* O, float lambda_init) {
    const int lane = opq(F.lane);
    const float d1 = wave_sum(A.in[I_DF_LQ1][lane] * A.in[I_DF_LK1][lane]), d2 = wave_sum(A.in[I_DF_LQ2][lane] * A.in[I_DF_LK2][lane]);
    const float lam = expf(d1) - expf(d2) + lambda_init;
    float sg[16];
#pragma unroll
    for (int i = 0; i < 16; ++i) sg[i] = A.in[I_DF_SUB][(lane & 7) * 16 + i] * (1.0f - lambda_init);
    for (int m = F.gw; m < M; m += F.NGW) {
        const GAS v4u* a = (const GAS v4u*)(OC + (size_t)m * D + lane * 16); const GAS v4u* bq = (const GAS v4u*)(OC + ((size_t)M + m) * D + lane * 16);
        float o[16]; float ss = 0.f;
#pragma unroll
        for (int i = 0; i < 2; ++i) { float x[8], y[8]; unpack8(a[i], x); unpack8(bq[i], y);
#pragma unroll
            for (int e = 0; e < 8; ++e) { const float v = x[e] - lam * y[e]; o[8 * i + e] = v; ss += v * v; } }
        ss += __shfl_xor(ss, 1); ss += __shfl_xor(ss, 2); ss += __shfl_xor(ss, 4);
        const float rstd = 1.0f / sqrtf(ss * (1.f / 128.f) + EPS);
        float t0[8], t1[8];
#pragma unroll
        for (int i = 0; i < 8; ++i) { t0[i] = o[i] * rstd * sg[i]; t1[i] = o[8 + i] * rstd * sg[8 + i]; }
        GAS v4u* op = (GAS v4u*)(O + (size_t)m * D + lane * 16); op[0] = pack8(t0); op[1] = pack8(t1);
    }
}
__device__ __forceinline__ void diff_attn_phase2(Frame& F, const Args& A, const bf16* QKV, bf16* OB, float lambda_init, char* lds_generic) {
    const int lane = opq(F.lane);
    const float d1 = wave_sum(A.in[I_DF_LQ1][lane] * A.in[I_DF_LK1][lane]), d2 = wave_sum(A.in[I_DF_LQ2][lane] * A.in[I_DF_LK2][lane]);
    const float lam = expf(d1) - expf(d2) + lambda_init;
    float gqm = fabsf(A.in[I_DF_QN][lane]), gkm = fabsf(A.in[I_DF_KN][lane]);
#pragma unroll
    for (int o_ = 1; o_ < 64; o_ <<= 1) { gqm = fmaxf(gqm, __shfl_xor(gqm, o_)); gkm = fmaxf(gkm, __shfl_xor(gkm, o_)); }
    const float off = fminf(8.0f * 1.4426950408889634f * gqm * gkm * 1.02f, 60.0f);
    constexpr size_t TEN = (size_t)32 << 20;
    for (int i = 0;; ++i) { const int Lu = i * F.G + F.vcu; if (Lu >= BATCH * 8 * 8) break;
        const int qb = Lu & 7, h8 = (Lu >> 3) & 7, b = Lu >> 6;
        dattn::diff_unit(QKV, QKV + TEN, QKV + 2 * TEN, OB, b, h8, qb * 256, lam, A.in[I_DF_SUB], 1.0f - lambda_init, EPS, off, lds_generic, F.tid); }
}
struct NaDesc {
    static constexpr bool HAS_BIAS = true;
    const bf16* QKV; const LAS float* rpb; bf16* O; int b, h, r, cb, R0, w0; float off;
    __device__ __forceinline__ int ntiles() const { return 9; }
    __device__ __forceinline__ size_t qtok(int qi) const { return (size_t)(b * SEQ + (r + (qi >> 4)) * 64 + 16 * cb + (qi & 15)); }
    static constexpr int VOFF = 32 << 20;
    __device__ __forceinline__ const bf16* qptr(int qi) const { return QKV + ((size_t)(b * 16 + h) * SEQ + (r + (qi >> 4)) * 64 + 16 * cb + (qi & 15)) * 64; }
    __device__ __forceinline__ const bf16* row_ptr(int t, int row) const { const int kr = min(R0 + t, 31); return QKV + (size_t)VOFF + ((size_t)(b * 16 + h) * SEQ + kr * 64 + w0 + row) * 64; }
    __device__ __forceinline__ void bounds(int t, int qi, int& lo, int& hb) const {
        const int qrow = r + (qi >> 4), qc = 16 * cb + (qi & 15), kr = R0 + t, r0q = min(max(qrow - 4, 0), 24), csq = min(max(qc - 8, 0), 48);
        const bool row_ok = (kr >= r0q) && (kr < r0q + 8);
        lo = row_ok ? csq - w0 : 64; hb = row_ok ? csq - w0 + 15 : 64; }
    __device__ __forceinline__ const LAS float* bias_base(int t, int qi) const { const int qrow = r + (qi >> 4), qc = 16 * cb + (qi & 15); return rpb + (R0 + t - qrow + 7) * 31 + (w0 - qc + 15); }
    __device__ __forceinline__ void store16(int qi, int ch, wattn::u32x4 v) const { *(GAS wattn::u32x4*)(O + qtok(qi) * D + h * 64 + 8 * ch) = v; }
    __device__ __forceinline__ void lse(int, float) const {}
};
__device__ __forceinline__ void na_attn_phase(Frame& F, const bf16* QKV, const float* rpb, bf16* O, const float* qg, const float* kg) {
    const int lane = opq(F.lane); const wattn::lds_ptr wl = (wattn::lds_ptr)(F.lds + RING_OFF + F.wave * 10752);
    LAS float* bl = (LAS float*)(F.lds + RING_OFF + F.wave * 10752 + 8704); int hcur = -1; float off = 0.f;
    float gqm = fabsf(qg[lane]), gkm = fabsf(kg[lane]);
#pragma unroll
    for (int o_ = 1; o_ < 64; o_ <<= 1) { gqm = fmaxf(gqm, __shfl_xor(gqm, o_)); gkm = fmaxf(gkm, __shfl_xor(gkm, o_)); }
    const float qkb = 8.0f * 1.4426950408889634f * gqm * gkm * 1.02f;
    for (int it = F.gw; it < BATCH * NH * 16 * 4; it += F.NGW) {
        { const int hn_ = (it >> 6) & 15;
          if (hn_ != hcur) { hcur = hn_; asm volatile("" ::: "memory"); float bm = 0.f;
              for (int i = lane; i < 15 * 31; i += 64) { const float v_ = rpb[hn_ * 15 * 31 + i] * 1.4426950408889634f; bl[i] = v_; bm = fmaxf(bm, fabsf(v_)); }
#pragma unroll
              for (int o_ = 1; o_ < 64; o_ <<= 1) bm = fmaxf(bm, __shfl_xor(bm, o_));
              off = fminf(qkb + bm, 60.0f); LDS_WAIT(); asm volatile("" ::: "memory"); } }
        NaDesc ds; ds.QKV = QKV; ds.rpb = bl; ds.O = O; ds.off = off; ds.cb = it & 3; ds.r = 2 * ((it >> 2) & 15); ds.h = (it >> 6) & 15; ds.b = it >> 10;
        ds.R0 = min(max(ds.r - 4, 0), 24); ds.w0 = (ds.cb == 0) ? 0 : (ds.cb == 1) ? 8 : (ds.cb == 2) ? 24 : 32;
        wattn::wave_attn(ds, wl, lane); }
}
struct DilDesc {
    static constexpr bool HAS_BIAS = false;
    const bf16* QKV; bf16* OG; float* LSE; int g, b, h, rho, j0, dsh, Lsub; float off;
    __device__ __forceinline__ int ntiles() const { return 5; }
    __device__ __forceinline__ size_t qtok(int qi) const { return (size_t)(b * SEQ + ((j0 + qi) << dsh) + rho); }
    static constexpr int VOFF = 32 << 20;
    __device__ __forceinline__ const bf16* qptr(int qi) const { return QKV + (size_t)(3 * g) * VOFF + ((size_t)(b * 16 + h) * SEQ + rho * Lsub + j0 + qi) * 64; }
    __device__ __forceinline__ const bf16* row_ptr(int t, int row) const { const int jk = min(max(j0 - 64 + 32 * t + row, 0), Lsub - 1); return QKV + (size_t)(3 * g + 1) * VOFF + ((size_t)(b * 16 + h) * SEQ + rho * Lsub + jk) * 64; }
    __device__ __forceinline__ void bounds(int t, int qi, int& lo, int& hb) const { const int jq = j0 + qi, base = j0 - 64 + 32 * t; lo = max(0, jq - 64) - base; hb = min(Lsub - 1, jq + 64) - base; }
    __device__ __forceinline__ const LAS float* bias_base(int, int) const { return nullptr; }
    __device__ __forceinline__ void store16(int qi, int ch, wattn::u32x4 v) const { *(GAS wattn::u32x4*)(OG + ((size_t)g * M + qtok(qi)) * D + h * 64 + 8 * ch) = v; }
    __device__ __forceinline__ void lse(int qi, float v) const { LSE[((size_t)g * M + qtok(qi)) * 16 + h] = v; }
};
__device__ __forceinline__ void dil_attn_phase(Frame& F, const bf16* QKV, bf16* OG, float* LSE) {
    const int lane = opq(F.lane); const wattn::lds_ptr wl = (wattn::lds_ptr)(F.lds + RING_OFF + F.wave * 10752);
    for (int it = F.gw; it < 3 * BATCH * NH * 64; it += F.NGW) {
        DilDesc ds; ds.QKV = QKV; ds.OG = OG; ds.LSE = LSE; const int sub = it & 63; ds.h = (it >> 6) & 15; ds.b = (it >> 10) & 15; ds.g = it >> 14;
        ds.dsh = 2 * ds.g; ds.Lsub = SEQ >> ds.dsh; const int nb = ds.Lsub >> 5; ds.rho = sub / nb; ds.j0 = 32 * (sub % nb);
        wattn::wave_attn(ds, wl, lane); }
}
__device__ __forceinline__ void conv_naive(Frame& F, const bf16* QKV, const float* cw, bf16* O) {
    const int lane = opq(F.lane);
    float w0[16], w1[16], w2[16];
#pragma unroll
    for (int i = 0; i < 16; ++i) { w0[i] = cw[lane * 16 + i]; w1[i] = cw[1024 + lane * 16 + i]; w2[i] = cw[2048 + lane * 16 + i]; }
    for (int m = F.gw; m < M; m += F.NGW) {
        const int s = m & (SEQ - 1);
        float acc[16];
#pragma unroll
        for (int i = 0; i < 16; ++i) acc[i] = 0.f;
#pragma unroll
        for (int w = 0; w < 3; ++w) { const int ss = s + w - 1; if (ss < 0 || ss >= SEQ) continue;
            const bf16* row = QKV + (size_t)(m + w - 1) * 3072 + lane * 16;
#pragma unroll
            for (int hf = 0; hf < 2; ++hf) { float cc[8], uu[8]; unpack8(*(const GAS v4u*)(row + 1024 + hf * 8), cc); unpack8(*(const GAS v4u*)(row + 2048 + hf * 8), uu);
#pragma unroll
                for (int e = 0; e < 8; ++e) { const float z = cc[e] * uu[e]; const float wv = (w == 0) ? w0[hf * 8 + e] : (w == 1) ? w1[hf * 8 + e] : w2[hf * 8 + e]; acc[hf * 8 + e] += wv * z; } } }
        const bf16* row = QKV + (size_t)m * 3072 + lane * 16;
#pragma unroll
        for (int hf = 0; hf < 2; ++hf) { float bb[8], t[8]; unpack8(*(const GAS v4u*)(row + hf * 8), bb);
#pragma unroll
            for (int e = 0; e < 8; ++e) t[e] = bb[e] * acc[hf * 8 + e];
            *(GAS v4u*)(O + (size_t)m * D + lane * 16 + hf * 8) = pack8(t); }
    }
}
__device__ __forceinline__ wattn::u32x4 w8(const v2u w) {
    typedef float f2_ __attribute__((ext_vector_type(2)));
    const f2_ a = __builtin_amdgcn_cvt_pk_f32_fp8((int)w.x, false) * 0.0625f, b = __builtin_amdgcn_cvt_pk_f32_fp8((int)w.x, true) * 0.0625f, c = __builtin_amdgcn_cvt_pk_f32_fp8((int)w.y, false) * 0.0625f, d = __builtin_amdgcn_cvt_pk_f32_fp8((int)w.y, true) * 0.0625f;
    return (wattn::u32x4){wattn::cvtpk(a.x, a.y), wattn::cvtpk(b.x, b.y), wattn::cvtpk(c.x, c.y), wattn::cvtpk(d.x, d.y)};
}
__device__ __forceinline__ void dil_attn_coop(Frame& F, const bf16* QKV, bf16* OG, float* LSE, const float* qg, const float* kg) {
    typedef __attribute__((address_space(3))) wattn::u32x4 lds_u32x4; typedef __attribute__((address_space(3))) wattn::bf16x8 lds_bf16x8;
    using wattn::crow; using wattn::cvtpk; using wattn::vtr; using wattn::f32x16; using wattn::bf16x8; using wattn::s16x4; using wattn::u32x4;
    constexpr int SLOT = 8704, VOFF = 32 << 20, NUNITS = 3 * BATCH * NH * 8;
    const int lane = opq(F.lane), wave = F.wave, r32 = lane & 31, hi = lane >> 5, lrow = lane >> 3, lch = lane & 7;
    const wattn::lds_ptr base = (wattn::lds_ptr)(F.lds + RING_OFF);
#define DU_DECODE(U, P) const int P##x = (U) & 7, P##h = ((U) >> 3) & 15, P##b = ((U) >> 7) & 15, P##g = (U) >> 11, P##dsh = 2 * P##g, P##Ls = SEQ >> P##dsh, P##nres = (P##g == 2) ? 2 : 1, P##qpr = (P##g == 2) ? 128 : 256, \
        P##rho0 = (P##g == 0) ? 0 : (P##g == 1) ? (P##x >> 1) : 2 * P##x, P##j0 = (P##g == 0) ? 256 * P##x : (P##g == 1) ? 256 * (P##x & 1) : 0, \
        P##kt0 = max(0, (P##j0 >> 5) - 2), P##kt1 = min((P##Ls >> 5) - 1, (P##j0 >> 5) + (P##qpr >> 5) + 1), P##nkt = P##kt1 - P##kt0 + 1, P##nsl = P##nres * P##nkt; \
        const unsigned char* P##Kt = (const unsigned char*)QKV + (size_t)(3 * P##g + 1) * VOFF + ((size_t)(P##b * 16 + P##h) * SEQ) * 64
    v2u tl[12], qn[4];
    float gqm = fabsf(qg[lane]), gkm = fabsf(kg[lane]);
#pragma unroll
    for (int o_ = 1; o_ < 64; o_ <<= 1) { gqm = fmaxf(gqm, __shfl_xor(gqm, o_)); gkm = fmaxf(gkm, __shfl_xor(gkm, o_)); }
    const float off = fminf(8.0f * 1.4426950408889634f * gqm * gkm * 1.02f, 60.0f);
#define DU_LOAD(P) do { _Pragma("unroll") for (int s = 0; s < 12; ++s) if (s < P##nsl) { const int r_ = (s >= P##nkt) ? 1 : 0, kt_ = P##kt0 + ((s >= P##nkt) ? s - P##nkt : s), row_ = 8 * (wave & 3) + lrow;   \
            const unsigned char* p_ = P##Kt + ((size_t)((P##rho0 + r_) * P##Ls + kt_ * 32 + row_)) * 64 + lch * 8 + ((wave >= 4) ? VOFF : 0); tl[s] = *(const v2u*)p_; } \
        { const int res_ = (P##g == 2) ? (wave >> 2) : 0, wq_ = (P##g == 2) ? (wave & 3) : wave; const unsigned char* qp_ = (const unsigned char*)QKV + (size_t)(3 * P##g) * VOFF + ((size_t)(P##b * 16 + P##h) * SEQ + (P##rho0 + res_) * P##Ls + P##j0 + 32 * wq_ + r32) * 64; \
          _Pragma("unroll") for (int d0 = 0; d0 < 4; ++d0) qn[d0] = *(const v2u*)(qp_ + 16 * d0 + 8 * hi); } } while (0)
#define DU_WRITE(P) do { _Pragma("unroll") for (int s = 0; s < 12; ++s) if (s < P##nsl) { const int row_ = 8 * (wave & 3) + lrow; \
            *(lds_u32x4*)(base + s * SLOT + ((wave >= 4) ? (4608 + row_ * 128) : (row_ * 144)) + lch * 16) = w8(tl[s]); } } while (0)
    int u = F.vcu;
    if (u >= NUNITS) return;
    { DU_DECODE(u, c); DU_LOAD(c); DU_WRITE(c); }
    bf16x8 qf[4];
#pragma unroll
    for (int d0 = 0; d0 < 4; ++d0) qf[d0] = __builtin_bit_cast(bf16x8, w8(qn[d0]));
    __syncthreads();
    for (; u < NUNITS; u += F.G) {
        DU_DECODE(u, c);
        const int un = u + F.G; const bool has_next = un < NUNITS;
        if (has_next) { DU_DECODE(un, n); DU_LOAD(n); }
        const int res = (cg == 2) ? (wave >> 2) : 0, wq = (cg == 2) ? (wave & 3) : wave, jq0 = cj0 + 32 * wq;
        f32x16 o0, o1; float l = 0.f;
#pragma unroll
        for (int r = 0; r < 16; ++r) { o0[r] = 0.f; o1[r] = 0.f; }
        for (int t = 0; t < 5; ++t) {
            const int kt = (jq0 >> 5) - 2 + t; if (kt < 0 || kt >= (cLs >> 5)) continue;
            const wattn::lds_ptr sb = base + (res * cnkt + kt - ckt0) * SLOT;
            bf16x8 kf[4];
#pragma unroll
            for (int d0 = 0; d0 < 4; ++d0) kf[d0] = *(const lds_bf16x8*)(sb + r32 * 144 + hi * 16 + 32 * d0);
            f32x16 p;
#pragma unroll
            for (int r = 0; r < 16; ++r) p[r] = -off;
#pragma unroll
            for (int d0 = 0; d0 < 4; ++d0) p = __builtin_amdgcn_mfma_f32_32x32x16_bf16(kf[d0], qf[d0], p, 0, 0, 0);
            const int jq = jq0 + r32, kb = kt * 32, lo = max(0, jq - 64) - kb, hb = min(cLs - 1, jq + 64) - kb;
            if (!__all(lo <= 0 && hb >= 31)) { const unsigned w = (unsigned)(hb - lo); const int dd = 4 * hi - lo;
#pragma unroll
                for (int r = 0; r < 16; ++r) p[r] = ((unsigned)((r & 3) + 8 * (r >> 2) + dd) <= w) ? p[r] : -INFINITY; }
            { typedef float f32x2_ __attribute__((ext_vector_type(2))); f32x2_ s2 = {0.f, 0.f};
#pragma unroll
              for (int r = 0; r < 16; ++r) p[r] = __builtin_amdgcn_exp2f(p[r]);
#pragma unroll
              for (int r = 0; r < 16; r += 2) s2 += (f32x2_){p[r], p[r + 1]};
              float rs = s2.x + s2.y; rs += __shfl_xor(rs, 32); l += rs; }
            const u32x4 pw0 = (u32x4){cvtpk(p[0], p[1]), cvtpk(p[2], p[3]), cvtpk(p[4], p[5]), cvtpk(p[6], p[7])};
            const u32x4 pw1 = (u32x4){cvtpk(p[8], p[9]), cvtpk(p[10], p[11]), cvtpk(p[12], p[13]), cvtpk(p[14], p[15])};
            const bf16x8 pa0 = __builtin_bit_cast(bf16x8, pw0), pa1 = __builtin_bit_cast(bf16x8, pw1);
            const wattn::lds_ptr vr = sb + 4608 + (4 * hi + ((lane & 15) >> 2)) * 128 + ((lane >> 4) & 1) * 32 + (lane & 3) * 8;
#pragma unroll
            for (int s = 0; s < 2; ++s) {
#pragma unroll
                for (int dh = 0; dh < 2; ++dh) {
                    const s16x4 lo4 = vtr(vr + (16 * s) * 128 + dh * 64), hh = vtr(vr + (16 * s + 8) * 128 + dh * 64);
                    const bf16x8 vf = (bf16x8){lo4[0], lo4[1], lo4[2], lo4[3], hh[0], hh[1], hh[2], hh[3]};
                    if (dh == 0) o0 = __builtin_amdgcn_mfma_f32_32x32x16_bf16(s == 0 ? pa0 : pa1, vf, o0, 0, 0, 0);
                    else o1 = __builtin_amdgcn_mfma_f32_32x32x16_bf16(s == 0 ? pa0 : pa1, vf, o1, 0, 0, 0);
                } }
        }
        __syncthreads();
        { const wattn::lds_ptr ow = base + wave * SLOT + 4608; const float rl = 32.0f / l;
          asm volatile("" ::: "memory");
#pragma unroll
          for (int r = 0; r < 16; ++r) { const int qi = crow(r, hi); const float a_ = __shfl(rl, qi);
              { const int w2_ = __builtin_amdgcn_cvt_pk_fp8_f32(__builtin_amdgcn_fmed3f(o0[r] * a_, -448.f, 448.f), __builtin_amdgcn_fmed3f(o1[r] * a_, -448.f, 448.f), 0, false);
                *(__attribute__((address_space(3))) unsigned char*)(ow + qi * 64 + r32) = (unsigned char)(w2_ & 0xff); *(__attribute__((address_space(3))) unsigned char*)(ow + qi * 64 + 32 + r32) = (unsigned char)((w2_ >> 8) & 0xff); } }
          asm volatile("" ::: "memory");
          const size_t tok0 = (size_t)cb * SEQ + crho0 + res;
#pragma unroll
          for (int i = 0; i < 2; ++i) { const int row = (lane >> 2) + 16 * i, c4 = lane & 3; const u32x4 w = *(const lds_u32x4*)(ow + row * 64 + c4 * 16);
              *(GAS u32x4*)((unsigned char*)OG + ((size_t)cg * M + tok0 + ((size_t)(jq0 + row) << cdsh)) * D + ch * 64 + 16 * c4) = w; }
          if (hi == 0) LSE[((size_t)cg * M + tok0 + ((size_t)(jq0 + r32) << cdsh)) * 16 + ch] = (off + __builtin_amdgcn_logf(l)) * 0.6931471805599453f;
          asm volatile("" ::: "memory"); }
        __syncthreads();
        if (has_next) { DU_DECODE(un, n); DU_WRITE(n);
#pragma unroll
            for (int d0 = 0; d0 < 4; ++d0) qf[d0] = __builtin_bit_cast(bf16x8, w8(qn[d0])); }
        __syncthreads();
    }
#undef DU_WRITE
#undef DU_LOAD
#undef DU_DECODE
}
__device__ __forceinline__ void dil_merge(Frame& F, const unsigned char* OG8, const float* LSE, unsigned char* O8) {
    const int lane = opq(F.lane), h = lane >> 2; typedef float f2_ __attribute__((ext_vector_type(2)));
    for (int m = F.gw; m < M; m += F.NGW) {
        const float l0 = LSE[(size_t)m * 16 + h], l1 = LSE[((size_t)M + m) * 16 + h], l2 = LSE[((size_t)2 * M + m) * 16 + h];
        const float mx = fmaxf(l0, fmaxf(l1, l2)); float a0 = __expf(l0 - mx), a1 = __expf(l1 - mx), a2 = __expf(l2 - mx); const float rs = 0.5f / (a0 + a1 + a2); a0 *= rs; a1 *= rs; a2 *= rs;
        const v4u x0 = *(const GAS v4u*)(OG8 + (size_t)m * D + lane * 16), x1 = *(const GAS v4u*)(OG8 + ((size_t)M + m) * D + lane * 16), x2 = *(const GAS v4u*)(OG8 + ((size_t)2 * M + m) * D + lane * 16);
        v4u o;
#pragma unroll
        for (int w = 0; w < 4; ++w) { const f2_ p0 = __builtin_amdgcn_cvt_pk_f32_fp8((int)x0[w], false), p1 = __builtin_amdgcn_cvt_pk_f32_fp8((int)x0[w], true), q0 = __builtin_amdgcn_cvt_pk_f32_fp8((int)x1[w], false), q1 = __builtin_amdgcn_cvt_pk_f32_fp8((int)x1[w], true),
                r0 = __builtin_amdgcn_cvt_pk_f32_fp8((int)x2[w], false), r1 = __builtin_amdgcn_cvt_pk_f32_fp8((int)x2[w], true);
            o[w] = pg8::pk4_fp8(a0 * p0.x + a1 * q0.x + a2 * r0.x, a0 * p0.y + a1 * q0.y + a2 * r0.y, a0 * p1.x + a1 * q1.x + a2 * r1.x, a0 * p1.y + a1 * q1.y + a2 * r1.y); }
        *(GAS v4u*)(O8 + (size_t)m * D + lane * 16) = o;
    }
}

__device__ __forceinline__ void router_finish(float (&a)[16], const int lane, const int m, float* AFFT) {
    { const bool h = (lane & 32) != 0;
#pragma unroll
      for (int e = 0; e < 8; ++e) { const float send = h ? a[e] : a[e + 8], keep = h ? a[e + 8] : a[e]; a[e] = keep + __shfl_xor(send, 32); } }
    { const bool h = (lane & 16) != 0;
#pragma unroll
      for (int e = 0; e < 4; ++e) { const float send = h ? a[e] : a[e + 4], keep = h ? a[e + 4] : a[e]; a[e] = keep + __shfl_xor(send, 16); } }
    { const bool h = (lane & 8) != 0;
#pragma unroll
      for (int e = 0; e < 2; ++e) { const float send = h ? a[e] : a[e + 2], keep = h ? a[e + 2] : a[e]; a[e] = keep + __shfl_xor(send, 8); } }
    { const bool h = (lane & 4) != 0; const float send = h ? a[0] : a[1], keep = h ? a[1] : a[0]; a[0] = keep + __shfl_xor(send, 4); }
    float lg = a[0]; lg += __shfl_xor(lg, 1); lg += __shfl_xor(lg, 2);
    float mx = lg;
#pragma unroll
    for (int o = 4; o < 64; o <<= 1) mx = fmaxf(mx, __shfl_xor(mx, o));
    const float val = expf(lg - mx); float sum = val;
#pragma unroll
    for (int o = 4; o < 64; o <<= 1) sum += __shfl_xor(sum, o);
    if ((lane & 3) == 0) AFFT[((size_t)(m >> 11) * 16 + (lane >> 2)) * SEQ + (m & 2047)] = val / sum;
}
template <bool XF32> __device__ __forceinline__ void norm2_router(Frame& F, const Args& A, int L, const void* xsrc) {
    const int lane = opq(F.lane); LAS float* wl = (LAS float*)(F.lds + RING_OFF);
    const float* wr = A.in[I_ROUTER] + (size_t)L * D * NE;
    for (int idx = opq(F.tid); idx < D * NE; idx += NWAVES * 64) wl[(idx & 15) * 1024 + (idx >> 4)] = wr[idx];
    __syncthreads();
    const float* g = A.in[I_GFFN] + (size_t)L * D; f32x4 gg[4];
#pragma unroll
    for (int j = 0; j < 4; ++j) gg[j] = ((const GAS f32x4*)g)[lane + 64 * j];
    unsigned char* HN8 = (unsigned char*)(F.ws + WS_HN8); float* AFFT = (float*)(F.ws + WS_AFFT);
    const int step = 2 * F.NGW;
    XRow<XF32> xc0, xc1, xn0, xn1;
    { const int m1 = (F.gw + F.NGW < M) ? F.gw + F.NGW : F.gw; xc0.load(xsrc, F.gw, lane); xc1.load(xsrc, m1, lane); }
    for (int m = F.gw; m < M; m += step) {
        const int m1 = (m + F.NGW < M) ? m + F.NGW : m;
        { const int n0 = (m + step < M) ? m + step : m, n1 = (n0 + F.NGW < M) ? n0 + F.NGW : n0; xn0.load(xsrc, n0, lane); xn1.load(xsrc, n1, lane); }
        f32x4 v0[4], v1[4]; xc0.get(v0); xc1.get(v1);
        rms_apply(v0, gg); rms_apply(v1, gg);
        { GAS unsigned* o4 = (GAS unsigned*)(HN8 + (size_t)m * D) + lane; GAS unsigned* o5 = (GAS unsigned*)(HN8 + (size_t)m1 * D) + lane;
#pragma unroll
          for (int j = 0; j < 4; ++j) { o4[64 * j] = pg8::pk4_fp8(v0[j].x * 16.f, v0[j].y * 16.f, v0[j].z * 16.f, v0[j].w * 16.f); o5[64 * j] = pg8::pk4_fp8(v1[j].x * 16.f, v1[j].y * 16.f, v1[j].z * 16.f, v1[j].w * 16.f); } }
        typedef float f2r __attribute__((ext_vector_type(2)));
        float a0[16], a1[16];
#pragma unroll
        for (int e = 0; e < 16; ++e) { f2r p0 = {0.f, 0.f}, q0 = {0.f, 0.f}, p1 = {0.f, 0.f}, q1 = {0.f, 0.f};
#pragma unroll
            for (int j = 0; j < 4; ++j) { const f32x4 w4 = *(const LAS f32x4*)(wl + e * 1024 + 256 * j + 4 * lane); const f2r wxy = {w4.x, w4.y}, wzw = {w4.z, w4.w};
                p0 = __builtin_elementwise_fma((f2r){v0[j].x, v0[j].y}, wxy, p0); q0 = __builtin_elementwise_fma((f2r){v0[j].z, v0[j].w}, wzw, q0);
                p1 = __builtin_elementwise_fma((f2r){v1[j].x, v1[j].y}, wxy, p1); q1 = __builtin_elementwise_fma((f2r){v1[j].z, v1[j].w}, wzw, q1); }
            { const f2r t0 = p0 + q0, t1 = p1 + q1; a0[e] = t0.x + t0.y; a1[e] = t1.x + t1.y; }
            if ((e & 3) == 3) asm volatile("" : "+v"(a0[e - 3]), "+v"(a0[e - 2]), "+v"(a0[e - 1]), "+v"(a0[e]), "+v"(a1[e - 3]), "+v"(a1[e - 2]), "+v"(a1[e - 1]), "+v"(a1[e]) :: "memory"); }
        router_finish(a0, lane, m, AFFT); router_finish(a1, lane, m1, AFFT);
        xc0 = xn0; xc1 = xn1;
    }
    __syncthreads();
}
__device__ __forceinline__ void topk_gather_phase(Frame& F) {
    LAS int* cw = (LAS int*)(F.lds + RING_OFF);
    LAS int* sel = (LAS int*)(F.lds + RING_OFF + 1024);
    const float* AFFT = (const float*)(F.ws + WS_AFFT); int* IDX = (int*)(F.ws + WS_IDX); float* GATE = (float*)(F.ws + WS_GATE); int* SLOTOF = (int*)(F.ws + WS_SLOTOF);
    const unsigned char* HN8 = (const unsigned char*)(F.ws + WS_HN8); unsigned char* XIN = (unsigned char*)(F.ws + WS_XIN);
    const int tid = opq(F.tid), lane = tid & 63, wave = F.wave;
    for (int u = blockIdx.x; u < BATCH * NE; u += F.G) {
        const int b = u >> 4, e = u & 15;
        const f32x4 a4 = *(const GAS f32x4*)(AFFT + (size_t)u * SEQ + 4 * tid);
        unsigned k[4];
#pragma unroll
        for (int q = 0; q < 4; ++q) k[q] = __float_as_uint(a4[q]);
        unsigned cand = 0u;
        for (int bit = 30; bit >= 0; --bit) {
            const unsigned tr = cand | (1u << bit);
            int c = 0;
#pragma unroll
            for (int q = 0; q < 4; ++q) c += __builtin_popcountll(__ballot(k[q] >= tr));
            LAS int* cb = cw + (bit & 1) * 8;
            if (lane == 0) cb[wave] = c;
            __syncthreads();
            int tot = 0;
#pragma unroll
            for (int w = 0; w < 8; ++w) tot += cb[w];
            if (tot >= CAP) cand = tr;
        }
        int cg = 0, ce = 0;
#pragma unroll
        for (int q = 0; q < 4; ++q) { cg += (k[q] > cand) ? 1 : 0; ce += (k[q] == cand) ? 1 : 0; }
        int pk = cg | (ce << 16), inc = pk;
#pragma unroll
        for (int o = 1; o < 64; o <<= 1) { const int t = __shfl_up(inc, o); if (lane >= o) inc += t; }
        __syncthreads();
        if (lane == 63) cw[16 + wave] = inc;
        __syncthreads();
        int woff = 0, total = 0;
#pragma unroll
        for (int w = 0; w < 8; ++w) { const int t = cw[16 + w]; if (w < wave) woff += t; total += t; }
        const int count_gt = total & 0xffff;
        int pg = ((woff + inc - pk) & 0xffff), pe = ((woff + inc - pk) >> 16);
        const int slotbase = (e * BATCH + b) * CAP;
#pragma unroll
        for (int q = 0; q < 4; ++q) { const int i = 4 * tid + q, tokrow = b * SEQ + i; int slot = -1;
            if (k[q] > cand) { slot = pg; ++pg; }
            else if (k[q] == cand) { if (count_gt + pe < CAP) slot = count_gt + pe; ++pe; }
            if (slot >= 0) { IDX[slotbase + slot] = tokrow; GATE[slotbase + slot] = a4[q]; sel[slot] = tokrow; }
            SLOTOF[(size_t)tokrow * 16 + e] = slot; }
        __syncthreads();
#pragma unroll
        for (int g8 = 0; g8 < 4; ++g8) { v4u t[8];
#pragma unroll
            for (int j = 0; j < 8; ++j) { const int s = wave + 8 * (8 * g8 + j); t[j] = ((const GAS v4u*)(HN8 + (size_t)sel[s] * D))[lane]; }
#pragma unroll
            for (int j = 0; j < 8; ++j) { const int s = wave + 8 * (8 * g8 + j); ((GAS v4u*)(XIN + (size_t)(slotbase + s) * D))[lane] = t[j]; } }
        __syncthreads();
    }
}
template <bool XF32, bool OF32> __device__ __forceinline__ void combine_norm(Frame& F, const float* gnext, const bool out_fp8, const void* xsrc, void* xdst) {
    const int lane = opq(F.lane); const int* SLOTOF = (const int*)(F.ws + WS_SLOTOF); const unsigned char* Y = (const unsigned char*)(F.ws + WS_Y); bf16* HN = (bf16*)(F.ws + WS_HN);
    f32x4 gg[4];
#pragma unroll
    for (int j = 0; j < 4; ++j) gg[j] = gnext ? ((const GAS f32x4*)gnext)[lane + 64 * j] : (f32x4){0.f, 0.f, 0.f, 0.f};
    int so; XRow<XF32> xc, xn;
    xc.load(xsrc, F.gw, lane); so = SLOTOF[(size_t)F.gw * 16 + (lane & 15)];
    for (int m = F.gw; m < M; m += F.NGW) {
        const int mn = (m + F.NGW < M) ? m + F.NGW : m;
        xn.load(xsrc, mn, lane);
        const int nso = SLOTOF[(size_t)mn * 16 + (lane & 15)];
        f32x4 v[4]; xc.get(v);
        const int b = m >> 11;
        unsigned yv[16][4]; int se[16];
#pragma unroll
        for (int e = 0; e < 16; ++e) { se[e] = __shfl(so, e);
            if (se[e] >= 0) { const GAS unsigned* yr = (const GAS unsigned*)(Y + ((size_t)((e * BATCH + b) * CAP + se[e])) * D) + lane;
#pragma unroll
                for (int j = 0; j < 4; ++j) yv[e][j] = yr[64 * j]; } }
#pragma unroll
        for (int e = 0; e < 16; ++e) {
            if (se[e] >= 0) {
#pragma unroll
                for (int j = 0; j < 4; ++j) { typedef float f2_ __attribute__((ext_vector_type(2))); const f2_ lo = __builtin_amdgcn_cvt_pk_f32_fp8((int)yv[e][j], false), hi = __builtin_amdgcn_cvt_pk_f32_fp8((int)yv[e][j], true);
                    v[j].x += lo.x * (1.0f / 64.0f); v[j].y += lo.y * (1.0f / 64.0f); v[j].z += hi.x * (1.0f / 64.0f); v[j].w += hi.y * (1.0f / 64.0f); } } }
        if (OF32) { GAS f32x4* xw = (GAS f32x4*)((float*)xdst + (size_t)m * D) + lane;
#pragma unroll
          for (int j = 0; j < 4; ++j) xw[64 * j] = v[j]; }
        else store_row_bf16((bf16*)xdst + (size_t)m * D, lane, v);
        if (gnext) { rms_apply(v, gg);
            if (out_fp8) { GAS unsigned* o4 = (GAS unsigned*)((unsigned char*)HN + (size_t)m * D) + lane;
#pragma unroll
                for (int j = 0; j < 4; ++j) o4[64 * j] = pg8::pk4_fp8(v[j].x * 16.f, v[j].y * 16.f, v[j].z * 16.f, v[j].w * 16.f); }
            else store_row_bf16(HN + (size_t)m * D, lane, v); }
        xc = xn; so = nso;
    }
}

#ifndef PROBE_DUP
#define PROBE_DUP 0
#endif
#ifndef PROBE_L
#define PROBE_L 15
#endif
#define REP(bit) _Pragma("unroll") for (int rep_ = 0; rep_ < (((PROBE_DUP >> (bit)) & 1) & ((PROBE_L >> L) & 1)) + 1; ++rep_)
constexpr int PPL = 11;
constexpr int NPHASE = 1 + NLAYER * PPL;
template <int L> __device__ __forceinline__ void layer_body(const Args& args, const int lo, const int hi, unsigned char* lds_raw, const int wave_s) {
#define IN(k) (lo <= (k) && (k) < hi)
#define SEAM(k) do { if (IN(k) && IN((k) + 1)) { const XcdBarrier bar_ = make_bar(args, lds_raw); const Frame Fb_ = make_frame(args, lds_raw, wave_s); xcd_barrier(bar_, Fb_.tid == 0); } } while (0)
    unsigned char* ws = args.ws;
    bf16* HN = (bf16*)(ws + WS_HN); bf16* QKV = (bf16*)(ws + WS_QKV); bf16* OB = (bf16*)(ws + WS_O);

        const int pb = 1 + L * PPL;
        const int nqkv = (L == 3) ? 9216 : 3072;
        REP(4) {
        if (IN(pb + 0)) { Frame F = make_frame(args, lds_raw, wave_s);
            constexpr bool Q8 = (L == 3);
            pg8::Gemm g{HN, (const bf16*)(ws + wqkv_off(L)), M, nqkv, Q8 ? D / 2 : D}; pg8::StaticOrder S; S.init(M, nqkv, F.G, (int)blockIdx.x);
            const float* qg = (L == 0) ? args.in[I_NA_QN] : (L == 1) ? args.in[I_DF_QN] : args.in[I_DL_QN]; const float* kg = (L == 0) ? args.in[I_NA_KN] : (L == 1) ? args.in[I_DF_KN] : args.in[I_DL_KN];
            pg8::EpiQKV E{QKV, nqkv, qg, kg, (L == 1 || L == 3) ? (const float*)(ws + WS_ROPE) : nullptr, attn_body::C2  , (L == 2) ? 1 : 0, EPS, Q8 ? 1.0f / 4096.0f : 1.0f, (L == 0) ? 1 : (L == 1) ? 2 : (L == 2) ? 0 : 3};
            pg8::gemm_phase<pg8::EpiQKV, pg8::StaticOrder, true, true, Q8>(F.lds + RING_OFF, g, S, E, F.tid);
        } SEAM(pb + 0);
        }
        REP(3) {
        if (IN(pb + 2)) { Frame F = make_frame(args, lds_raw, wave_s);
            if constexpr (L == 0) na_attn_phase(F, QKV, args.in[I_NA_RPB], OB, args.in[I_NA_QN], args.in[I_NA_KN]);
            else if constexpr (L == 1) diff_attn_phase2(F, args, QKV, OB, 0.8f - 0.6f * 0.7408182206817179f, (char*)lds_raw);
            else if constexpr (L == 2) conv_naive(F, QKV, args.in[I_SC_CONV], OB);
            else dil_attn_coop(F, QKV, (bf16*)(ws + WS_OG), (float*)(ws + WS_LSE), args.in[I_DL_QN], args.in[I_DL_KN]);
        } SEAM(pb + 2);
        }
        REP(6) {
        if (IN(pb + 3)) { Frame F = make_frame(args, lds_raw, wave_s);
            if constexpr (L == 3) dil_merge(F, (const unsigned char*)(ws + WS_OG), (const float*)(ws + WS_LSE), (unsigned char*)OB);
        } if constexpr (L == 3) SEAM(pb + 3);
        }
        REP(5) {
        if (IN(pb + 4)) { Frame F = make_frame(args, lds_raw, wave_s);
            constexpr bool O8 = (L == 3);
            pg8::Gemm g{OB, (const bf16*)(ws + WS_WOUT + (size_t)L * 2 * MiB), M, D, O8 ? D / 2 : D}; pg8::StaticOrder S; S.init(M, D, F.G, (int)blockIdx.x);
            if constexpr (L == 0) { pg8::EpiResidB<true> E{args.in[I_X], (bf16*)(ws + WS_XB), D, 1.0f}; pg8::gemm_phase<pg8::EpiResidB<true>, pg8::StaticOrder, true, true, false>(F.lds + RING_OFF, g, S, E, F.tid); }
            else { pg8::EpiResidB<false> E{ws + WS_XB, (bf16*)(ws + WS_XB), D, O8 ? 1.0f / 4096.0f : 1.0f}; pg8::gemm_phase<pg8::EpiResidB<false>, pg8::StaticOrder, true, true, O8>(F.lds + RING_OFF, g, S, E, F.tid); }
        } SEAM(pb + 4);
        }
        REP(1) {
        if (IN(pb + 5)) { Frame F = make_frame(args, lds_raw, wave_s); norm2_router<false>(F, args, L, ws + WS_XB); } SEAM(pb + 5);
        }
        REP(1) {
        if (IN(pb + 6)) { Frame F = make_frame(args, lds_raw, wave_s); topk_gather_phase(F); } SEAM(pb + 6);
        }
        REP(1) {
        }
        REP(2) {
        if (IN(pb + 8)) { Frame F = make_frame(args, lds_raw, wave_s);
            pg8::Gemm g{(const bf16*)(ws + WS_XIN), (const bf16*)(ws + WS_WGU + (size_t)L * 64 * MiB), NSLOT, 2 * DFF, D / 2}; pg8::MoeOrder S; S.init(NE, 16, 16, F.G, F.vcu, 1);
            pg8::EpiSwiglu8 E{(unsigned char*)(ws + WS_HMID), DFF, 16, 1.0f / (16.0f * 256.0f), 8.0f};
            pg8::gemm_phase<pg8::EpiSwiglu8, pg8::MoeOrder, true, true, true>(F.lds + RING_OFF, g, S, E, F.tid);
        } SEAM(pb + 8);
        }
        REP(7) {
        if (IN(pb + 9)) { Frame F = make_frame(args, lds_raw, wave_s);
            pg8::Gemm g{(const bf16*)(ws + WS_HMID), (const bf16*)(ws + WS_WDN + (size_t)L * 32 * MiB), NSLOT, D, DFF / 2}; pg8::MoeOrder S; S.init(NE, 16, 4, F.G, F.vcu);
            pg8::EpiGate E{(unsigned char*)(ws + WS_Y), D, 4, (const float*)(ws + WS_GATE), 64.0f / (8.0f * 256.0f)};
            pg8::gemm_phase<pg8::EpiGate, pg8::MoeOrder, true, true, true>(F.lds + RING_OFF, g, S, E, F.tid);
        } SEAM(pb + 9);
        }
        if (IN(pb + 10)) { Frame F = make_frame(args, lds_raw, wave_s); const float* gnext = L + 1 < NLAYER ? args.in[I_GMIX] + (size_t)(L + 1) * D : nullptr;
            if constexpr (L + 1 < NLAYER) combine_norm<false, false>(F, gnext, (L + 1) == 3, ws + WS_XB, ws + WS_XB);
            else combine_norm<false, true>(F, gnext, false, ws + WS_XB, F.out); } SEAM(pb + 10);
    #undef IN
#undef SEAM
}
__global__ void __launch_bounds__(NWAVES * 64, 2) fwd_kernel(Args args) {
    extern __shared__ __attribute__((aligned(16))) unsigned char lds[];
    { const int tid0 = threadIdx.x; for (int u = tid0; u < (LDS_BYTES - LDSCTL_OFF) / 4; u += NWAVES * 64) ((LAS unsigned*)((LAS unsigned char*)lds + LDSCTL_OFF))[u] = 0u; }
    __syncthreads();
    const int wave_s = __builtin_amdgcn_readfirstlane((int)threadIdx.x >> 6);
    const int lo = args.ph_lo, hi = args.ph_hi;
    if (hi - lo > 1) (void)xcd_barrier_post((unsigned*)((gu32*)(args.ws + WS_CTL) + CW_BAR) + args.li * XCD_BAR_WORDS, (volatile LAS unsigned*)((LAS unsigned char*)lds + MISC_OFF) + 8);
#define IN(k) (lo <= (k) && (k) < hi)
#define SEAM(k) do { if (IN(k) && IN((k) + 1)) { const XcdBarrier bar_ = make_bar(args, lds); const Frame Fb_ = make_frame(args, lds, wave_s); xcd_barrier(bar_, Fb_.tid == 0); } } while (0)
    { constexpr int L = 0; REP(0) { if (IN(0)) { Frame F = make_frame(args, lds, wave_s); p0_prologue(F, args); } SEAM(0); } }
#ifdef PROBE_BARS
    for (int xb_ = 0; xb_ < PROBE_BARS; ++xb_) { const XcdBarrier bar_ = make_bar(args, lds); const Frame Fb_ = make_frame(args, lds, wave_s); xcd_barrier(bar_, Fb_.tid == 0); }
#endif

    layer_body<0>(args, lo, hi, lds, wave_s); layer_body<1>(args, lo, hi, lds, wave_s); layer_body<2>(args, lo, hi, lds, wave_s); layer_body<3>(args, lo, hi, lds, wave_s);
#undef IN
#undef SEAM
}

#ifndef MK_N_LAUNCHES
#define MK_N_LAUNCHES 1
#endif
extern "C" void kernel_launch(void* const* d_in, const int* in_sizes, int n_in, void* d_out, int out_size, void* d_ws, size_t ws_size, hipStream_t stream) {
    static int grid = 0;
    if (grid == 0) {
        if (n_in != N_IN || in_sizes[0] != M * D || out_size != M * D || ws_size < WS_END) { fprintf(stderr, "kernel_launch: unexpected shapes: n_in %d in0 %d out %d ws %zu (need %zu)\n", n_in, n_in > 0 ? in_sizes[0] : -1, out_size, ws_size, (size_t)WS_END); grid = -1; return; }
        int dev = 0, cus = 0, per_cu = 0;
        if (hipGetDevice(&dev) != hipSuccess || hipDeviceGetAttribute(&cus, hipDeviceAttributeMultiprocessorCount, dev) != hipSuccess) { grid = -1; return; }
        if (hipFuncSetAttribute((const void*)fwd_kernel, hipFuncAttributeMaxDynamicSharedMemorySize, LDS_BYTES) != hipSuccess) { fprintf(stderr, "kernel_launch: hipFuncSetAttribute failed\n"); grid = -1; return; }
        if (hipOccupancyMaxActiveBlocksPerMultiprocessor(&per_cu, (const void*)fwd_kernel, NWAVES * 64, LDS_BYTES) != hipSuccess || per_cu < 1) fprintf(stderr, "kernel_launch: occupancy query reports %d\n", per_cu);
        (void)hipGetLastError();
        grid = cus;
    }
    if (grid < 0) return;
    if (hipMemsetAsync((char*)d_ws + WS_CTL, 0, CTL_ZERO_BYTES, stream) != hipSuccess) return;
    Args a{};
    for (int i = 0; i < N_IN; ++i) a.in[i] = (const float*)d_in[i];
    a.out = (float*)d_out; a.ws = (unsigned char*)d_ws; a.pad = 0;
    if (MK_N_LAUNCHES == 1) {
        a.ph_lo = 0; a.ph_hi = NPHASE; a.li = 0;
        hipLaunchKernelGGL(fwd_kernel, dim3(grid), dim3(NWAVES * 64), LDS_BYTES, stream, a);
    } else {
        for (int p = 0; p < NPHASE; ++p) { a.ph_lo = p; a.ph_hi = p + 1; a.li = 0;
            hipLaunchKernelGGL(fwd_kernel, dim3(grid), dim3(NWAVES * 64), LDS_BYTES, stream, a); }
    }
    const hipError_t le = hipPeekAtLastError();
    if (le != hipSuccess) fprintf(stderr, "kernel_launch: launch failed: %s\n", hipGetErrorName(le));
}
```

```cpp
#include <hip/hip_runtime.h>
#include <cstdio>
#include <cstdint>
namespace pg8 {
#define PG8_LAS __attribute__((address_space(3)))
typedef unsigned short bf16_t;
typedef short bf16x8 __attribute__((ext_vector_type(8)));
typedef float f32x4 __attribute__((ext_vector_type(4)));
typedef unsigned u32x4 __attribute__((ext_vector_type(4)));
constexpr int BM = 256, BK = 64, HALF = 128, HTB = HALF * BK * 2  , STAGE_BYTES = 8 * HTB, NXCD = 8, WGM = 8;

__host__ __device__ __forceinline__ int lds_byte(int r, int c) { const int st = (r >> 4) * 2 + (c >> 5), rr = r & 15, cc = c & 31, ob = rr * 64 + cc * 2; return st * 1024 + (ob ^ (((ob >> 9) & 1) << 5)); }
__host__ __device__ __forceinline__ void stage_rc(int b, int& R, int& C) { const int st = b / 1024, sb = b % 1024, swz = sb ^ (((sb >> 9) & 1) << 5); R = (st >> 1) * 16 + swz / 64; C = (st & 1) * 32 + (swz % 64) / 2; }
__host__ __device__ __forceinline__ int perm32(int rho) { const int n = rho >> 4, i = rho & 15; return 8 * (i >> 2) + 4 * n + (i & 3); }

struct Unit { int pm, pn; };
struct Gemm { const bf16_t* A; const bf16_t* Bt; int M, N, K; };

struct StaticOrder {
    int nM, nN, nwg, G, c;
    __host__ __device__ void init(int M, int N, int G_, int c_) { nM = M / BM; nN = N / BM; nwg = nM * nN; G = G_; c = c_; }
    __host__ __device__ bool next(int i, Unit& u) const {
        const long L = (long)i * G + c; if (L >= nwg) return false;
        int wgid = (int)L; { const int q = nwg / NXCD, r = nwg % NXCD, xcd = wgid % NXCD, off = wgid / NXCD; wgid = (xcd < r ? xcd * (q + 1) : r * (q + 1) + (xcd - r) * q) + off; }
        const int nig = WGM * nN, gid = wgid / nig, fm = gid * WGM, gsz = (nM - fm) < WGM ? (nM - fm) : WGM;
        u.pm = fm + ((wgid % nig) % gsz); u.pn = (wgid % nig) / gsz; return true;
    }
    __device__ __forceinline__ void a_ready(const Unit&) const {}
    __device__ __forceinline__ void done(const Unit&) const {}
};

__device__ __forceinline__ unsigned cvt_pk_bf16(float lo, float hi) { unsigned r; asm volatile("v_cvt_pk_bf16_f32 %0, %1, %2" : "=v"(r) : "v"(lo), "v"(hi)); return r; }
typedef float f32x2 __attribute__((ext_vector_type(2)));
__device__ __forceinline__ f32x2 gelu_pk(f32x2 v) {
    const f32x2 av = __builtin_elementwise_abs(v), d = av * 0.2316418882f + 1.0f;
    f32x2 t; t.x = __builtin_amdgcn_rcpf(d.x); t.y = __builtin_amdgcn_rcpf(d.y);
    f32x2 q = t * 0.5307027145f + (-0.7265760135f); q = q * t + 0.7107068705f; q = q * t + (-0.142248368f); q = q * t + 0.127414796f; q = q * t;
    const f32x2 s = (v * v) * (-0.72134752044f);
    f32x2 e; e.x = __builtin_amdgcn_exp2f(s.x); e.y = __builtin_amdgcn_exp2f(s.y);
    const f32x2 m = v * (q * e), r = v - m;
    f32x2 o; o.x = v.x < 0.f ? m.x : r.x; o.y = v.y < 0.f ? m.y : r.y; return o;
}

template <int ACT  > struct EpiBf16 {
    static constexpr bool PERM = true, AFTER_DRAIN = false; static_assert(ACT == 0 || ACT == 1, "EpiBf16: ACT is 0 (none) or 1 (gelu_pk)");
    bf16_t* O; int ldc; const float* bias; int split_cols; size_t split_stride; float scale0;
    __device__ __forceinline__ void operator()(const f32x4 (&acc)[2][2][4][2], const Unit& u, int wr, int wc, int fr, int fq) const {
        const int row0 = u.pm * BM + wr * 64 + fr; int colt = u.pn * BM; bf16_t* base = O;
        float sc = 1.f; if (split_cols) { const int t = colt / split_cols; base += (size_t)t * split_stride; colt -= t * split_cols; if (t == 0) sc = scale0; }
        const int col0 = colt + wc * 32 + 8 * fq, bcol0 = u.pn * BM + wc * 32 + 8 * fq;
        f32x4 bv[2][2];
#pragma unroll
        for (int bj = 0; bj < 2; ++bj)
#pragma unroll
            for (int n = 0; n < 2; ++n) bv[bj][n] = bias ? *(const f32x4*)(bias + bcol0 + bj * HALF + 4 * n) : (f32x4){0.f, 0.f, 0.f, 0.f};
#pragma unroll
        for (int ai = 0; ai < 2; ++ai)
#pragma unroll
            for (int m = 0; m < 4; ++m) { bf16_t* rowp = base + (size_t)(row0 + ai * HALF + m * 16) * ldc + col0;
#pragma unroll
                for (int bj = 0; bj < 2; ++bj) { f32x4 v0 = acc[ai][bj][m][0] + bv[bj][0], v1 = acc[ai][bj][m][1] + bv[bj][1];
                    if (ACT == 1) { f32x2 a = gelu_pk((f32x2){v0[0], v0[1]}), b = gelu_pk((f32x2){v0[2], v0[3]}), c = gelu_pk((f32x2){v1[0], v1[1]}), d = gelu_pk((f32x2){v1[2], v1[3]});
                        v0 = (f32x4){a.x, a.y, b.x, b.y}; v1 = (f32x4){c.x, c.y, d.x, d.y}; }
                    v0 = v0 * sc; v1 = v1 * sc; u32x4 w; w.x = cvt_pk_bf16(v0[0], v0[1]); w.y = cvt_pk_bf16(v0[2], v0[3]); w.z = cvt_pk_bf16(v1[0], v1[1]); w.w = cvt_pk_bf16(v1[2], v1[3]);
                    *(u32x4*)(rowp + bj * HALF) = w; } }
    }
};
struct EpiStore {
    static constexpr bool PERM = true, AFTER_DRAIN = false;
    bf16_t* O; int ldc; int ntn; float sc;
    __device__ __forceinline__ void operator()(const f32x4 (&acc)[2][2][4][2], const Unit& u, int wr, int wc, int fr, int fq) const {
        const int row0 = u.pm * BM + wr * 64 + fr; const int col0 = (u.pn % ntn) * BM + wc * 32 + 8 * fq;
#pragma unroll
        for (int ai = 0; ai < 2; ++ai)
#pragma unroll
            for (int m = 0; m < 4; ++m) { bf16_t* rowp = O + (size_t)(row0 + ai * HALF + m * 16) * ldc + col0;
#pragma unroll
                for (int bj = 0; bj < 2; ++bj) { const f32x4 v0 = acc[ai][bj][m][0] * sc, v1 = acc[ai][bj][m][1] * sc;
                    u32x4 w; w.x = cvt_pk_bf16(v0[0], v0[1]); w.y = cvt_pk_bf16(v0[2], v0[3]); w.z = cvt_pk_bf16(v1[0], v1[1]); w.w = cvt_pk_bf16(v1[2], v1[3]);
                    *(u32x4*)(rowp + bj * HALF) = w; } }
    }
};
template <bool XF32> struct EpiResidB {
    static constexpr bool PERM = true, AFTER_DRAIN = false;
    const void* X; bf16_t* O; int ldc; float sc;
    __device__ __forceinline__ void operator()(const f32x4 (&acc)[2][2][4][2], const Unit& u, int wr, int wc, int fr, int fq) const {
        const int row0 = u.pm * BM + wr * 64 + fr; const int col0 = u.pn * BM + wc * 32 + 8 * fq;
#pragma unroll
        for (int ai = 0; ai < 2; ++ai)
#pragma unroll
            for (int mh = 0; mh < 2; ++mh) {
                f32x4 xa[2][2][2];
#pragma unroll
                for (int mm = 0; mm < 2; ++mm)
#pragma unroll
                    for (int bj = 0; bj < 2; ++bj) { const size_t off = (size_t)(row0 + ai * HALF + (2 * mh + mm) * 16) * ldc + col0 + bj * HALF;
                        if constexpr (XF32) { xa[mm][bj][0] = *(const f32x4*)((const float*)X + off); xa[mm][bj][1] = *(const f32x4*)((const float*)X + off + 4); }
                        else { const u32x4 w = *(const u32x4*)((const bf16_t*)X + off);
                            xa[mm][bj][0] = (f32x4){__uint_as_float(w.x << 16), __uint_as_float(w.x & 0xffff0000u), __uint_as_float(w.y << 16), __uint_as_float(w.y & 0xffff0000u)};
                            xa[mm][bj][1] = (f32x4){__uint_as_float(w.z << 16), __uint_as_float(w.z & 0xffff0000u), __uint_as_float(w.w << 16), __uint_as_float(w.w & 0xffff0000u)}; } }
#pragma unroll
                for (int mm = 0; mm < 2; ++mm)
#pragma unroll
                    for (int bj = 0; bj < 2; ++bj) { const int m = 2 * mh + mm; const size_t off = (size_t)(row0 + ai * HALF + m * 16) * ldc + col0 + bj * HALF;
                        const f32x4 v0 = acc[ai][bj][m][0] * sc + xa[mm][bj][0], v1 = acc[ai][bj][m][1] * sc + xa[mm][bj][1];
                        u32x4 w; w.x = cvt_pk_bf16(v0[0], v0[1]); w.y = cvt_pk_bf16(v0[2], v0[3]); w.z = cvt_pk_bf16(v1[0], v1[1]); w.w = cvt_pk_bf16(v1[2], v1[3]);
                        *(u32x4*)(O + off) = w; } }
    }
};
__device__ __forceinline__ unsigned pk4_fp8(float a, float b, float c, float d) {
    a = __builtin_amdgcn_fmed3f(a, -448.f, 448.f); b = __builtin_amdgcn_fmed3f(b, -448.f, 448.f); c = __builtin_amdgcn_fmed3f(c, -448.f, 448.f); d = __builtin_amdgcn_fmed3f(d, -448.f, 448.f);
    int w = 0; w = __builtin_amdgcn_cvt_pk_fp8_f32(a, b, w, false); w = __builtin_amdgcn_cvt_pk_fp8_f32(c, d, w, true); return (unsigned)w; }
struct EpiQKV {
    static constexpr bool PERM = true, AFTER_DRAIN = false;
    bf16_t* O; int ldc; const float* qg; const float* kg; const float* rope; float qscale; int plain; float eps; float asc;
    int layout;
    __device__ __forceinline__ bf16_t* rowptr(int row, int pn, int wc, int fq) const {
        if (layout == 0) return O + (size_t)row * ldc + pn * BM + 64 * wc + 8 * fq;
        const int g = pn / 12, t = (pn % 12) >> 2, c64 = ((pn & 3) << 2) + wc, b = row >> 11; int pos = row & 2047;
        if (layout == 3) { const int dsh = 2 * g; pos = ((pos & ((1 << dsh) - 1)) << (11 - dsh)) + (pos >> dsh); }
        bf16_t* base = O + (size_t)(3 * g + t) * (32u << 20);
        if (layout == 2 && t == 2) return base + ((size_t)((b * 8 + (c64 >> 1)) * 2048 + pos)) * 128 + (c64 & 1) * 64 + 8 * fq;
        return base + ((size_t)((b * 16 + c64) * 2048 + pos)) * 64 + 8 * fq;
    }
    __device__ __forceinline__ void operator()(const f32x4 (&acc)[2][2][4][2], const Unit& u, int wr, int wc, int fr, int fq) const {
        const int t12 = u.pn % 12, mode = plain ? 2 : (t12 < 4 ? 0 : (t12 < 8 ? 1 : 2));
        const int row0 = u.pm * BM + wr * 64 + fr;
        if (mode == 2) {
#pragma unroll
            for (int ai = 0; ai < 2; ++ai)
#pragma unroll
                for (int m = 0; m < 4; ++m) { bf16_t* rowp = rowptr(row0 + ai * HALF + m * 16, u.pn, wc, fq);
#pragma unroll
                    for (int bj = 0; bj < 2; ++bj) { const f32x4 v0 = acc[ai][bj][m][0] * asc, v1 = acc[ai][bj][m][1] * asc;
                        u32x4 w; w.x = cvt_pk_bf16(v0[0], v0[1]); w.y = cvt_pk_bf16(v0[2], v0[3]); w.z = cvt_pk_bf16(v1[0], v1[1]); w.w = cvt_pk_bf16(v1[2], v1[3]);
                        if (layout == 3) { typedef unsigned u32x2q __attribute__((ext_vector_type(2))); u32x2q w8; w8.x = pk4_fp8(v0[0] * 16.f, v0[1] * 16.f, v0[2] * 16.f, v0[3] * 16.f); w8.y = pk4_fp8(v1[0] * 16.f, v1[1] * 16.f, v1[2] * 16.f, v1[3] * 16.f);
                            *(u32x2q*)((unsigned char*)O + (rowp - O) + bj * 32) = w8; }
                        else *(u32x4*)(rowp + bj * 32) = w; } }
        } else {
            const float* gs = mode ? kg : qg; const float sc = mode ? 1.0f : qscale;
            float g0[8], g1[8];
#pragma unroll
            for (int i = 0; i < 8; ++i) { g0[i] = gs[8 * fq + i] * sc; g1[i] = gs[32 + 8 * fq + i] * sc; }
#pragma unroll
            for (int ai = 0; ai < 2; ++ai)
#pragma unroll
                for (int m = 0; m < 4; ++m) { const int row = row0 + ai * HALF + m * 16; bf16_t* rowp = rowptr(row, u.pn, wc, fq);
                    float y0[8], y1[8];
#pragma unroll
                    for (int i = 0; i < 4; ++i) { y0[i] = acc[ai][0][m][0][i] * asc; y0[4 + i] = acc[ai][0][m][1][i] * asc; y1[i] = acc[ai][1][m][0][i] * asc; y1[4 + i] = acc[ai][1][m][1][i] * asc; }
                    float ss = 0.f;
#pragma unroll
                    for (int i = 0; i < 8; ++i) ss += y0[i] * y0[i] + y1[i] * y1[i];
                    ss += __shfl_xor(ss, 16); ss += __shfl_xor(ss, 32);
                    const float rstd = __builtin_amdgcn_rsqf(ss * (1.f / 64.f) + eps);
#pragma unroll
                    for (int i = 0; i < 8; ++i) { y0[i] *= rstd * g0[i]; y1[i] *= rstd * g1[i]; }
                    if (rope) { const f32x4* rp = (const f32x4*)(rope + ((size_t)(row & 2047) * 32 + 8 * fq) * 2);
#pragma unroll
                        for (int i2 = 0; i2 < 4; ++i2) { const f32x4 cs = rp[i2];
                            const float a0 = y0[2 * i2], b0 = y1[2 * i2], a1 = y0[2 * i2 + 1], b1 = y1[2 * i2 + 1];
                            y0[2 * i2] = a0 * cs[0] - b0 * cs[1]; y1[2 * i2] = b0 * cs[0] + a0 * cs[1];
                            y0[2 * i2 + 1] = a1 * cs[2] - b1 * cs[3]; y1[2 * i2 + 1] = b1 * cs[2] + a1 * cs[3]; } }
                    u32x4 w0, w1;
                    w0.x = cvt_pk_bf16(y0[0], y0[1]); w0.y = cvt_pk_bf16(y0[2], y0[3]); w0.z = cvt_pk_bf16(y0[4], y0[5]); w0.w = cvt_pk_bf16(y0[6], y0[7]);
                    w1.x = cvt_pk_bf16(y1[0], y1[1]); w1.y = cvt_pk_bf16(y1[2], y1[3]); w1.z = cvt_pk_bf16(y1[4], y1[5]); w1.w = cvt_pk_bf16(y1[6], y1[7]);
                    if (layout == 3) { typedef unsigned u32x2q __attribute__((ext_vector_type(2))); u32x2q a8, b8; unsigned char* r8 = (unsigned char*)O + (rowp - O);
                        a8.x = pk4_fp8(y0[0] * 16.f, y0[1] * 16.f, y0[2] * 16.f, y0[3] * 16.f); a8.y = pk4_fp8(y0[4] * 16.f, y0[5] * 16.f, y0[6] * 16.f, y0[7] * 16.f);
                        b8.x = pk4_fp8(y1[0] * 16.f, y1[1] * 16.f, y1[2] * 16.f, y1[3] * 16.f); b8.y = pk4_fp8(y1[4] * 16.f, y1[5] * 16.f, y1[6] * 16.f, y1[7] * 16.f);
                        *(u32x2q*)r8 = a8; *(u32x2q*)(r8 + 32) = b8; }
                    else { *(u32x4*)rowp = w0; *(u32x4*)(rowp + 32) = w1; } }
        }
    }
};
struct EpiResid {
    static constexpr bool PERM = false, AFTER_DRAIN = false;
    const float* base; float* out; int ldc;
    __device__ __forceinline__ void operator()(const f32x4 (&acc)[2][2][4][2], const Unit& u, int wr, int wc, int fr, int fq) const {
        const int row0 = u.pm * BM + wr * 64 + fr; const int col0 = u.pn * BM + wc * 32 + 4 * fq;
#pragma unroll
        for (int ai = 0; ai < 2; ++ai)
#pragma unroll
            for (int m = 0; m < 4; ++m) { const size_t off = (size_t)(row0 + ai * HALF + m * 16) * ldc + col0;
#pragma unroll
                for (int bj = 0; bj < 2; ++bj)
#pragma unroll
                    for (int n = 0; n < 2; ++n) { const f32x4 b = *(const f32x4*)(base + off + bj * HALF + n * 16); *(f32x4*)(out + off + bj * HALF + n * 16) = b + acc[ai][bj][m][n]; } }
    }
};
struct EpiSwiglu {
    static constexpr bool PERM = true, AFTER_DRAIN = false;
    bf16_t* O; int ldc; int ntn;
    __device__ __forceinline__ void operator()(const f32x4 (&acc)[2][2][4][2], const Unit& u, int wr, int wc, int fr, int fq) const {
        typedef unsigned u32x2v __attribute__((ext_vector_type(2)));
        const int row0 = u.pm * BM + wr * 64 + fr; const int col0 = (u.pn % ntn) * HALF + wc * 16 + 4 * fq;
#pragma unroll
        for (int ai = 0; ai < 2; ++ai)
#pragma unroll
            for (int m = 0; m < 4; ++m) { bf16_t* rowp = O + (size_t)(row0 + ai * HALF + m * 16) * ldc + col0;
#pragma unroll
                for (int bj = 0; bj < 2; ++bj) { const f32x4 g = acc[ai][bj][m][0], uu = acc[ai][bj][m][1]; float h[4];
#pragma unroll
                    for (int e = 0; e < 4; ++e) h[e] = g[e] * __builtin_amdgcn_rcpf(1.0f + __expf(-g[e])) * uu[e];
                    u32x2v w; w.x = cvt_pk_bf16(h[0], h[1]); w.y = cvt_pk_bf16(h[2], h[3]);
                    *(u32x2v*)(rowp + bj * 64) = w; } }
    }
};
struct EpiSwiglu8 {
    static constexpr bool PERM = true, AFTER_DRAIN = false;
    unsigned char* O; int ldc; int ntn; float sin, sout;
    __device__ __forceinline__ void operator()(const f32x4 (&acc)[2][2][4][2], const Unit& u, int wr, int wc, int fr, int fq) const {
        typedef unsigned u32x2v __attribute__((ext_vector_type(2)));
        const int row0 = u.pm * BM + wr * 64 + fr; const int col0 = (u.pn % ntn) * HALF + wc * 32 + 8 * fq;
        const float c1 = -sin * 1.4426950408889634f, c2 = sin * sin * sout;
#pragma unroll
        for (int ai = 0; ai < 2; ++ai)
#pragma unroll
            for (int m = 0; m < 4; ++m) { unsigned char* rowp = O + (size_t)(row0 + ai * HALF + m * 16) * ldc + col0; u32x2v w;
#pragma unroll
                for (int n = 0; n < 2; ++n) { const f32x4 g = acc[ai][0][m][n], uu = acc[ai][1][m][n]; f32x2 h[2];
#pragma unroll
                    for (int p = 0; p < 2; ++p) { const f32x2 a = (f32x2){g[2 * p], g[2 * p + 1]}, b = (f32x2){uu[2 * p], uu[2 * p + 1]};
                        const f32x2 t = a * c1; f32x2 e_; e_.x = __builtin_amdgcn_exp2f(t.x); e_.y = __builtin_amdgcn_exp2f(t.y);
                        const f32x2 d = e_ + 1.0f; f32x2 r; r.x = __builtin_amdgcn_rcpf(d.x); r.y = __builtin_amdgcn_rcpf(d.y);
                        h[p] = ((a * c2) * b) * r; }
                    w[n] = pk4_fp8(h[0].x, h[0].y, h[1].x, h[1].y); }
                *(u32x2v*)rowp = w; }
    }
};
struct EpiGate {
    static constexpr bool PERM = true, AFTER_DRAIN = false;
    unsigned char* O; int ldc; int ntn; const float* gate; float sc;
    __device__ __forceinline__ void operator()(const f32x4 (&acc)[2][2][4][2], const Unit& u, int wr, int wc, int fr, int fq) const {
        typedef unsigned u32x2v __attribute__((ext_vector_type(2)));
        const int row0 = u.pm * BM + wr * 64 + fr; const int col0 = (u.pn % ntn) * BM + wc * 32 + 8 * fq;
#pragma unroll
        for (int ai = 0; ai < 2; ++ai)
#pragma unroll
            for (int m = 0; m < 4; ++m) { const int row = row0 + ai * HALF + m * 16; const float gs = gate[row] * sc; unsigned char* rowp = O + (size_t)row * ldc + col0;
#pragma unroll
                for (int bj = 0; bj < 2; ++bj) { const f32x4 v0 = acc[ai][bj][m][0] * gs, v1 = acc[ai][bj][m][1] * gs;
                    u32x2v w; w.x = pk4_fp8(v0[0], v0[1], v0[2], v0[3]); w.y = pk4_fp8(v1[0], v1[1], v1[2], v1[3]);
                    *(u32x2v*)(rowp + bj * HALF) = w; } }
    }
};
struct MoeOrder {
    int nN, mpe, total, G, v, blk4x8, own;
    __device__ void init(int nE, int mpe_, int nN_, int G_, int v_, int blk = 0) { nN = nN_; mpe = mpe_; total = nE * mpe_ * nN_; G = G_; v = v_; blk4x8 = (blk == 1) && (mpe_ == 16) && (nN_ == 16) && (G_ == 256); own = (blk == 3) && (mpe_ == 16) && (nN_ == 16) && (G_ == 256) && (nE == 16); }
    __device__ bool next(int i, Unit& u) const {
        if (own) { if (i >= 16) return false;
            const int x = v >> 5, j = v & 31, ex = 2 * x + (i >> 3), rr = i & 7, mg = rr >> 2, nq = rr & 3;
            u.pm = ex * mpe + 8 * mg + (j & 7); u.pn = ex * nN + 4 * nq + (j >> 3); return true; }
        const long L = (long)i * G + v; if (L >= total) return false;
        const int per = mpe * nN, e = (int)L / per, r = (int)L % per;
        if (blk4x8) { const int x = r >> 5, j = r & 31;
            u.pm = e * mpe + 4 * (x >> 1) + (j >> 3); u.pn = e * nN + 8 * (x & 1) + (j & 7); return true; }
        u.pm = e * mpe + r / nN; u.pn = e * nN + r % nN; return true;
    }
    __device__ __forceinline__ void a_ready(const Unit&) const {}
    __device__ __forceinline__ void done(const Unit&) const {}
};
typedef int i32x4_t __attribute__((ext_vector_type(4))); typedef int i32x8_t __attribute__((ext_vector_type(8)));
template <bool FP8> struct FragSel;
template <> struct FragSel<false> { struct T { bf16x8 k[2]; };
    static __device__ __forceinline__ void load(T& d, const PG8_LAS unsigned char* p) { d.k[0] = *(const PG8_LAS bf16x8*)p; d.k[1] = *(const PG8_LAS bf16x8*)(p + 1024); }
    static __device__ __forceinline__ void mma(f32x4& c, const T& w, const T& a) { c = __builtin_amdgcn_mfma_f32_16x16x32_bf16(w.k[0], a.k[0], c, 0, 0, 0); c = __builtin_amdgcn_mfma_f32_16x16x32_bf16(w.k[1], a.k[1], c, 0, 0, 0); } };
template <> struct FragSel<true> { typedef i32x8_t T;
    static __device__ __forceinline__ void load(T& d, const PG8_LAS unsigned char* p) { const i32x4_t lo = *(const PG8_LAS i32x4_t*)p, hi = *(const PG8_LAS i32x4_t*)(p + 1024); d = __builtin_shufflevector(lo, hi, 0, 1, 2, 3, 4, 5, 6, 7); }
    static __device__ __forceinline__ void mma(f32x4& c, const T& w, const T& a) { asm volatile("v_mfma_f32_16x16x128_f8f6f4 %0, %1, %2, %0" : "+v"(c) : "v"(w), "v"(a)); } };
template <class Epi, class Sched, bool ALIGN_EPI = false, bool SP2 = false, bool FP8 = false>
__device__ __forceinline__ void gemm_phase(PG8_LAS unsigned char* lds, const Gemm g, const Sched& S, const Epi& E, int tid_in) {
    int tid_ = tid_in; asm volatile("" : "+v"(tid_));
    const int tid = tid_, wid = __builtin_amdgcn_readfirstlane(tid >> 6), lane = tid & 63, wr = wid >> 2, wc = wid & 3, fr = lane & 15, fq = lane >> 4;
    const int K = g.K, nt = K / BK;
    unsigned voffA[2], voffB[2];
#pragma unroll
    for (int i = 0; i < 2; ++i) { int R, C; stage_rc(tid * 16 + i * 8192, R, C); const int Rb = Epi::PERM ? ((R & ~31) + perm32(R & 31)) : R;
        voffA[i] = (unsigned)(R * K + C) * 2u; voffB[i] = (unsigned)(Rb * K + C) * 2u; }
    const size_t kstep = (size_t)(BK * 2);
    const size_t hstep = (size_t)HALF * K * 2;
    const size_t tstep = 2 * hstep;
    const unsigned ldsw = (unsigned)wid * 1024u;
    const int aoff = lds_byte(wr * 64 + fr, fq * 8), boff = lds_byte(wc * 32 + fr, fq * 8);
#define PG8_SA(b, h) (((b) * 2 + (h)) * HTB)
#define PG8_SB(b, h) ((4 + (b) * 2 + (h)) * HTB)
#define PG8_STAGE(bufoff, gbase, voff) do { _Pragma("unroll") for (int _i = 0; _i < 2; ++_i) \
        __builtin_amdgcn_global_load_lds((const unsigned*)((const char*)(gbase) + (voff)[_i]), (PG8_LAS unsigned*)(lds + (bufoff) + ldsw + _i * 8192), 16, 0, 0); } while (0)
#define PG8_LDA(dst, b, h) do { _Pragma("unroll") for (int m = 0; m < 4; ++m) FragSel<FP8>::load(dst[m], lds + PG8_SA(b, h) + aoff + m * 2048); } while (0)
#define PG8_LDB(dst, b, h) do { _Pragma("unroll") for (int n = 0; n < 2; ++n) FragSel<FP8>::load(dst[n], lds + PG8_SB(b, h) + boff + n * 2048); } while (0)
#define PG8_MMA(ai, bj, At, Bt) do { __builtin_amdgcn_s_setprio(1); if constexpr (FP8) asm volatile("s_nop 1"); _Pragma("unroll") for (int m = 0; m < 4; ++m) _Pragma("unroll") for (int n = 0; n < 2; ++n) { \
        FragSel<FP8>::mma(acc[ai][bj][m][n], Bt[n], At[m]); } \
        __builtin_amdgcn_s_setprio(0); } while (0)
#define PG8_WAIT_V(n) asm volatile("s_waitcnt vmcnt(" #n ")" ::: "memory")
#define PG8_WAIT_L(n) asm volatile("s_waitcnt lgkmcnt(" #n ")" ::: "memory")
#define PG8_BAR __builtin_amdgcn_s_barrier()
#define PG8_SCHED __builtin_amdgcn_sched_barrier(0)
    Unit cur, nxt; int ui = 0;
    if (!S.next(0, cur)) return;
    f32x4 acc[2][2][4][2];
#pragma unroll
    for (int a = 0; a < 2; ++a)
#pragma unroll
        for (int b = 0; b < 2; ++b)
#pragma unroll
            for (int m = 0; m < 4; ++m)
#pragma unroll
                for (int n = 0; n < 2; ++n) acc[a][b][m][n] = (f32x4){0.f, 0.f, 0.f, 0.f};
    typename FragSel<FP8>::T At[4], B0[2], B1[2];
    const char* cA = (const char*)g.A + (size_t)cur.pm * tstep; const char* cB = (const char*)g.Bt + (size_t)cur.pn * tstep;
    S.a_ready(cur);
    if constexpr (SP2) {
        PG8_STAGE(PG8_SB(0, 0), cB, voffB); PG8_STAGE(PG8_SB(0, 1), cB + hstep, voffB); PG8_STAGE(PG8_SA(0, 0), cA, voffA); PG8_STAGE(PG8_SA(0, 1), cA + hstep, voffA);
        if (wr == 1) PG8_BAR;
        PG8_WAIT_V(2); PG8_BAR;
        PG8_STAGE(PG8_SB(1, 0), cB + kstep, voffB); PG8_STAGE(PG8_SA(1, 0), cA + kstep, voffA); PG8_STAGE(PG8_SB(1, 1), cB + hstep + kstep, voffB);
        PG8_WAIT_V(6); PG8_BAR;
    } else {
        PG8_STAGE(PG8_SB(0, 0), cB, voffB); PG8_STAGE(PG8_SA(0, 0), cA, voffA); PG8_STAGE(PG8_SB(0, 1), cB + hstep, voffB); PG8_STAGE(PG8_SA(0, 1), cA + hstep, voffA);
        if (wr == 1) PG8_BAR;
        PG8_WAIT_V(4); PG8_BAR;
        PG8_STAGE(PG8_SB(1, 0), cB + kstep, voffB); PG8_STAGE(PG8_SA(1, 0), cA + kstep, voffA); PG8_STAGE(PG8_SB(1, 1), cB + hstep + kstep, voffB);
        PG8_WAIT_V(6); PG8_BAR;
    }
    for (;;) {
        const bool has_next = S.next(ui + 1, nxt);
        const char* nA = has_next ? (const char*)g.A + (size_t)nxt.pm * tstep : cA; const char* nB = has_next ? (const char*)g.Bt + (size_t)nxt.pn * tstep : cB;
        for (int t = 0; t < nt; t += 2) {
            const bool last = (t == nt - 2);
            const char* a1 = cA + (size_t)(t + 1) * kstep;
            const char* a2 = last ? nA : cA + (size_t)(t + 2) * kstep; const char* b2 = last ? nB : cB + (size_t)(t + 2) * kstep;
            const char* a3 = a2 + kstep; const char* b3 = b2 + kstep;
            if (last && has_next) S.a_ready(nxt);
            if constexpr (SP2) {
            PG8_LDB(B0, 0, 0); PG8_LDB(B1, 0, 1); PG8_SCHED; PG8_LDA(At, 0, 0); PG8_STAGE(PG8_SA(1, 1), a1 + hstep, voffA);
            PG8_WAIT_V(8); PG8_WAIT_L(0); PG8_BAR; PG8_MMA(0, 0, At, B0); PG8_MMA(0, 1, At, B1); PG8_BAR; PG8_SCHED;
            PG8_LDA(At, 0, 1); PG8_STAGE(PG8_SB(0, 0), b2, voffB); PG8_STAGE(PG8_SB(0, 1), b2 + hstep, voffB); PG8_STAGE(PG8_SA(0, 0), a2, voffA);
            PG8_WAIT_V(8); PG8_WAIT_L(0); PG8_BAR; PG8_MMA(1, 0, At, B0); PG8_MMA(1, 1, At, B1); PG8_BAR; PG8_SCHED;
            PG8_LDB(B0, 1, 0); PG8_LDB(B1, 1, 1); PG8_SCHED; PG8_LDA(At, 1, 0); PG8_STAGE(PG8_SA(0, 1), a2 + hstep, voffA);
            PG8_WAIT_V(8); PG8_WAIT_L(0); PG8_BAR; PG8_MMA(0, 0, At, B0); PG8_MMA(0, 1, At, B1); PG8_BAR; PG8_SCHED;
            PG8_LDA(At, 1, 1); PG8_STAGE(PG8_SB(1, 0), b3, voffB); PG8_STAGE(PG8_SB(1, 1), b3 + hstep, voffB); PG8_STAGE(PG8_SA(1, 0), a3, voffA);
            PG8_WAIT_V(8); PG8_WAIT_L(0); PG8_BAR; PG8_MMA(1, 0, At, B0); PG8_MMA(1, 1, At, B1); PG8_BAR; PG8_SCHED;
            } else {
            PG8_LDB(B0, 0, 0); PG8_SCHED; PG8_LDA(At, 0, 0); PG8_STAGE(PG8_SA(1, 1), a1 + hstep, voffA);
            PG8_WAIT_L(8); PG8_BAR; PG8_WAIT_L(0); PG8_MMA(0, 0, At, B0); PG8_BAR; PG8_SCHED;
            PG8_LDB(B1, 0, 1); PG8_STAGE(PG8_SB(0, 0), b2, voffB);
            PG8_BAR; PG8_WAIT_L(0); PG8_MMA(0, 1, At, B1); PG8_BAR;
            PG8_LDA(At, 0, 1); PG8_STAGE(PG8_SA(0, 0), a2, voffA);
            PG8_BAR; PG8_WAIT_L(0); PG8_MMA(1, 0, At, B0); PG8_BAR; PG8_SCHED;
            PG8_STAGE(PG8_SB(0, 1), b2 + hstep, voffB);
            PG8_WAIT_V(6); PG8_BAR; PG8_MMA(1, 1, At, B1); PG8_BAR;
            PG8_LDB(B0, 1, 0); PG8_SCHED; PG8_LDA(At, 1, 0); PG8_STAGE(PG8_SA(0, 1), a2 + hstep, voffA);
            PG8_WAIT_L(8); PG8_BAR; PG8_WAIT_L(0); PG8_MMA(0, 0, At, B0); PG8_BAR; PG8_SCHED;
            PG8_LDB(B1, 1, 1); PG8_STAGE(PG8_SB(1, 0), b3, voffB);
            PG8_BAR; PG8_WAIT_L(0); PG8_MMA(0, 1, At, B1); PG8_BAR;
            PG8_LDA(At, 1, 1); PG8_STAGE(PG8_SA(1, 0), a3, voffA);
            PG8_BAR; PG8_WAIT_L(0); PG8_MMA(1, 0, At, B0); PG8_BAR; PG8_SCHED;
            PG8_STAGE(PG8_SB(1, 1), b3 + hstep, voffB);
            PG8_WAIT_V(6); PG8_BAR; PG8_MMA(1, 1, At, B1); PG8_BAR;
            }
        }
        if constexpr (ALIGN_EPI) { if (wr == 0) PG8_BAR; }
        if constexpr (FP8) { asm volatile("s_nop 15\n\ts_nop 15" ::: "memory"); }
        if constexpr (!Epi::AFTER_DRAIN) { E(acc, cur, wr, wc, fr, fq); S.done(cur); }
        if (!has_next) break;
#pragma unroll
        for (int a = 0; a < 2; ++a)
#pragma unroll
            for (int b = 0; b < 2; ++b)
#pragma unroll
                for (int m = 0; m < 4; ++m)
#pragma unroll
                    for (int n = 0; n < 2; ++n) acc[a][b][m][n] = (f32x4){0.f, 0.f, 0.f, 0.f};
        cur = nxt; cA = nA; cB = nB; ++ui;
        if constexpr (ALIGN_EPI) { if (wr == 1) PG8_BAR; }
    }
    PG8_WAIT_V(0);
    if constexpr (!ALIGN_EPI) { if (wr == 0) PG8_BAR; }
    PG8_BAR;
    if constexpr (Epi::AFTER_DRAIN) { E.fused(acc, cur, wr, wc, fr, fq, lds, wid, lane); S.done(cur); }
#undef PG8_SA
#undef PG8_SB
#undef PG8_STAGE
#undef PG8_LDA
#undef PG8_LDB
#undef PG8_MMA
#undef PG8_WAIT_V
#undef PG8_WAIT_L
#undef PG8_BAR
#undef PG8_SCHED
}
}
#define GAS __attribute__((address_space(1)))
#define LAS __attribute__((address_space(3)))
typedef unsigned short bf16;
typedef unsigned v4u __attribute__((ext_vector_type(4)));
typedef float f32x4 __attribute__((ext_vector_type(4)));
typedef short bf16x8 __attribute__((ext_vector_type(8)));
typedef GAS unsigned gu32;
typedef GAS unsigned long long gu64;
#define RLX_AGENT __ATOMIC_RELAXED, __HIP_MEMORY_SCOPE_AGENT
#define LDS_WAIT() asm volatile("s_waitcnt lgkmcnt(0)" ::: "memory")
#define VM_WAIT() asm volatile("s_waitcnt vmcnt(0)" ::: "memory")
__device__ __forceinline__ unsigned long long rt() { return __builtin_amdgcn_s_memrealtime(); }
__device__ __forceinline__ unsigned f2bf(float f) { unsigned u = __builtin_bit_cast(unsigned, f); return (u + 0x7fffu + ((u >> 16) & 1u)) >> 16; }
__device__ __forceinline__ unsigned pk2(float lo, float hi) { return f2bf(lo) | (f2bf(hi) << 16); }
#define XB_TMO      128
#define XB_XCNT(j)  (256  + 64 * (j))
#define XB_XSUB(j)  (1280 + 64 * (j))
#define XB_XGEN(j)  (2304 + 64 * (j))
#define XB_TOP      3328
#define XB_TOPGEN   3392
#define XCD_BAR_WORDS 3456
#define XB_SPIN_CAP (1u << 18)

__device__ __forceinline__ unsigned xb_ld(unsigned* p)              { return __hip_atomic_load(p, __ATOMIC_RELAXED, __HIP_MEMORY_SCOPE_AGENT); }
__device__ __forceinline__ unsigned xb_add(unsigned* p, unsigned v) { return __hip_atomic_fetch_add(p, v, __ATOMIC_RELAXED, __HIP_MEMORY_SCOPE_AGENT); }
__device__ __forceinline__ unsigned xb_xcc_id() { return (unsigned)__builtin_amdgcn_s_getreg((3 << 11) | 20) & 0xFu; }
#define XB_SPIN(cond, bar) do { unsigned _sp = 0; while (cond) { __builtin_amdgcn_s_sleep(1); \
    if ((++_sp & 255u) == 0u) { if (xb_ld(&(bar)[XB_TMO])) break; if (_sp > XB_SPIN_CAP) { atomicAdd(&(bar)[XB_TMO], 1u); break; } } } } while (0)

struct XcdBarrier {
    unsigned* bar; unsigned x;
    volatile LAS unsigned* st;
};

__device__ __forceinline__ XcdBarrier xcd_barrier_post(unsigned* bar, volatile LAS unsigned* st) {
    XcdBarrier b; b.bar = bar; b.x = xb_xcc_id(); b.st = st;
    if (threadIdx.x == 0) (void)xb_add(&bar[XB_XCNT(b.x)], 1u);
    return b;
}
__device__ __forceinline__ void xcd_barrier_complete(unsigned* bar, unsigned x, unsigned& nloc, unsigned& nx) {
    const unsigned G = gridDim.x * gridDim.y * gridDim.z;
    unsigned sum, cnt, mine, sp = 0u;
    for (;;) {
        sum = 0u; cnt = 0u; mine = 0u;
#pragma unroll
        for (unsigned j = 0; j < 16; ++j) { const unsigned c = xb_ld(&bar[XB_XCNT(j)]); sum += c; cnt += (c > 0u) ? 1u : 0u; mine = (j == x) ? c : mine; }
        if (sum == G) break;
        __builtin_amdgcn_s_sleep(1);
        if ((++sp & 255u) == 0u) { if (xb_ld(&bar[XB_TMO])) break; if (sp > XB_SPIN_CAP) { atomicAdd(&bar[XB_TMO], 1u); break; } }
    }
    nloc = mine > 0u ? mine : 1u; nx = cnt > 0u ? cnt : 1u;
}

__device__ __forceinline__ void xcd_barrier(const XcdBarrier& b, const bool t0  ) {
    asm volatile("s_waitcnt vmcnt(0)" ::: "memory");
    __syncthreads();
    if (t0) {
        unsigned* bar = b.bar;
        __builtin_amdgcn_s_waitcnt(0);
        unsigned nloc = b.st[0], nx = b.st[1];
        if (nloc == 0u) { xcd_barrier_complete(bar, b.x, nloc, nx); b.st[0] = nloc; b.st[1] = nx; }
        const unsigned old = xb_add(&bar[XB_XSUB(b.x)], 1u);
        const unsigned gen = old / nloc;
        if (old + 1u == (gen + 1u) * nloc) {
            __builtin_amdgcn_fence(__ATOMIC_RELEASE, "agent");
            asm volatile("s_waitcnt vmcnt(0)" ::: "memory");
            const unsigned og = xb_add(&bar[XB_TOP], 1u);
            const unsigned tg = og / nx;
            if (og + 1u == (tg + 1u) * nx) xb_add(&bar[XB_TOPGEN], 1u);
            else XB_SPIN(xb_ld(&bar[XB_TOPGEN]) == tg, bar);
            __builtin_amdgcn_fence(__ATOMIC_ACQUIRE, "agent");
            xb_add(&bar[XB_XGEN(b.x)], 1u);
            asm volatile("s_waitcnt vmcnt(0)" ::: "memory");
        } else {
            XB_SPIN(xb_ld(&bar[XB_XGEN(b.x)]) == gen, bar);
            __builtin_amdgcn_fence(__ATOMIC_ACQUIRE, "agent");
            asm volatile("s_waitcnt vmcnt(0)" ::: "memory");
        }
    }
    __syncthreads();
}
#include <hip/hip_bf16.h>
#include <cmath>
namespace attn_body {
using bf16=__hip_bfloat16;
using bf16x8=__attribute__((ext_vector_type(8)))short;
using s16x4=__attribute__((ext_vector_type(4)))short;
using f32x16=__attribute__((ext_vector_type(16)))float;
using u32x4=__attribute__((ext_vector_type(4)))unsigned;
constexpr int SEQ=2048,D=64,PQ=64,PK=64,PV=128,PO=1024;
constexpr int NW=8,QBLK=32,QB=QBLK*NW,KVBLK=64,NQB=SEQ/QB;
constexpr int ATTN_UNIT_ROWS=QB;
__device__ __forceinline__ int crow(int r,int hi){return (r&3)+8*(r>>2)+4*hi;}
#define SBAR() __builtin_amdgcn_sched_barrier(0)
__device__ __forceinline__ void cmask(f32x16&p0,f32x16&p1,int jb,int qrel,int hi){
  const float NEG=-INFINITY; int kb=64*jb+4*hi;
  #pragma unroll
  for(int r=0;r<16;++r){int kv=kb+(r&3)+8*(r>>2); if(kv>qrel)p0[r]=NEG; if(kv+32>qrel)p1[r]=NEG;}
}

constexpr int NSLOT=3, SLOTB=8192;
constexpr int LDS_K=0, LDS_V=NSLOT*SLOTB, LDS_WS=2*NSLOT*SLOTB, LDS_OST=LDS_WS+NW*64*4, LDS_BYTES=LDS_OST+NW*4096;
constexpr float C2=0.125f*1.4426950408889634f;
__device__ __forceinline__ void glds16(const void*gsrc,unsigned lds_dst){unsigned keep;
  asm volatile("s_mov_b32 %0, m0\n\ts_mov_b32 m0, %2\n\ts_nop 0\n\tglobal_load_lds_dwordx4 %1, off\n\ts_mov_b32 m0, %0":"=&s"(keep):"v"(gsrc),"s"(lds_dst):"memory");}
__device__ __forceinline__ float max3f(float a,float b,float c){float r;asm("v_max3_f32 %0, %1, %2, %3":"=v"(r):"v"(a),"v"(b),"v"(c));return r;}
__device__ __forceinline__ float max2f(float a,float b){float r;asm("v_max_f32_e32 %0, %1, %2":"=v"(r):"v"(a),"v"(b));return r;}
__device__ __forceinline__ float fadd_s(float a,float b){float r;asm("v_add_f32_e32 %0, %1, %2":"=v"(r):"v"(a),"v"(b));return r;}
__device__ __forceinline__ float fsub_s(float a,float b){float r;asm("v_sub_f32_e32 %0, %1, %2":"=v"(r):"v"(a),"v"(b));return r;}
typedef float f32x2_t __attribute__((ext_vector_type(2))); typedef __bf16 bf16x2_t __attribute__((ext_vector_type(2)));
__device__ __forceinline__ unsigned cvtpk_s(float lo,float hi){f32x2_t v={lo,hi};bf16x2_t b=__builtin_convertvector(v,bf16x2_t);return __builtin_bit_cast(unsigned,b);}
#define WAIT_BAR(N) asm volatile("s_waitcnt vmcnt(" #N ") lgkmcnt(0)\n\ts_barrier":::"memory")

__device__ __forceinline__ void qkt(f32x16&p0,f32x16&p1,const char*Kslot,const bf16x8*qr,const f32x16&negm,int r32,int hi){
  const char*kb=Kslot+hi*1024+r32*16;
  #pragma unroll
  for(int d0=0;d0<4;++d0){
    const bf16x8 b0=*reinterpret_cast<const bf16x8*>(kb+d0*2048);
    const bf16x8 b1=*reinterpret_cast<const bf16x8*>(kb+d0*2048+512);
    if(d0==0){p0=__builtin_amdgcn_mfma_f32_32x32x16_bf16(b0,qr[0],negm,0,0,0);p1=__builtin_amdgcn_mfma_f32_32x32x16_bf16(b1,qr[0],negm,0,0,0);}
    else{p0=__builtin_amdgcn_mfma_f32_32x32x16_bf16(b0,qr[d0],p0,0,0,0);p1=__builtin_amdgcn_mfma_f32_32x32x16_bf16(b1,qr[d0],p1,0,0,0);}}
}
typedef __attribute__((address_space(3))) const char* lds_cptr;
typedef short v4i16_t __attribute__((ext_vector_type(4)));
__device__ __forceinline__ void kload8(bf16x8*kf,lds_cptr kp){
  kf[0]=*(const __attribute__((address_space(3))) bf16x8*)(kp);      kf[1]=*(const __attribute__((address_space(3))) bf16x8*)(kp+512);
  kf[2]=*(const __attribute__((address_space(3))) bf16x8*)(kp+2048); kf[3]=*(const __attribute__((address_space(3))) bf16x8*)(kp+2560);
  kf[4]=*(const __attribute__((address_space(3))) bf16x8*)(kp+4096); kf[5]=*(const __attribute__((address_space(3))) bf16x8*)(kp+4608);
  kf[6]=*(const __attribute__((address_space(3))) bf16x8*)(kp+6144); kf[7]=*(const __attribute__((address_space(3))) bf16x8*)(kp+6656);
}
__device__ __forceinline__ void kload2(bf16x8*kf,lds_cptr kp,int j){ kf[2*j]=*(const __attribute__((address_space(3))) bf16x8*)(kp+j*2048); kf[2*j+1]=*(const __attribute__((address_space(3))) bf16x8*)(kp+j*2048+512); }
__device__ __forceinline__ s16x4 vtr(lds_cptr p){ return __builtin_bit_cast(s16x4,__builtin_amdgcn_ds_read_tr16_b64_v4i16((__attribute__((address_space(3))) v4i16_t*)p)); }
__device__ __forceinline__ float rowmax(const f32x16&p0,const f32x16&p1){
  float a=max3f(p0[0],p0[1],p1[0]),b=max3f(p0[2],p0[3],p1[1]);a=max3f(a,p1[2],p1[3]);
  #pragma unroll
  for(int r=4;r<16;r+=4){a=max3f(a,p0[r],p0[r+1]);b=max3f(b,p0[r+2],p0[r+3]);a=max3f(a,p1[r],p1[r+1]);b=max3f(b,p1[r+2],p1[r+3]);}
  const float m=max2f(a,b);
  auto rr=__builtin_amdgcn_permlane32_swap(__float_as_uint(m),__float_as_uint(m),false,false);
  return max2f(__uint_as_float(rr[0]),__uint_as_float(rr[1]));
}
__device__ __forceinline__ void pv(f32x16*o,int vb,bf16x8 pa0,bf16x8 pa1,bf16x8 pa2,bf16x8 pa3){
  #pragma unroll
  for(int d0=0;d0<2;++d0){s16x4 lo[4],hi[4];
    #pragma unroll
    for(int ks=0;ks<4;++ks){
      asm volatile("ds_read_b64_tr_b16 %0,%1 offset:%c2":"=&v"(lo[ks]):"v"(vb),"i"(d0*4096+ks*1024):"memory");
      asm volatile("ds_read_b64_tr_b16 %0,%1 offset:%c2":"=&v"(hi[ks]):"v"(vb),"i"(d0*4096+ks*1024+512):"memory");}
    asm volatile("s_waitcnt lgkmcnt(0)":::"memory");SBAR();
    #define PK(k) (bf16x8){lo[k][0],lo[k][1],lo[k][2],lo[k][3],hi[k][0],hi[k][1],hi[k][2],hi[k][3]}
    o[d0]=__builtin_amdgcn_mfma_f32_32x32x16_bf16(pa0,PK(0),o[d0],0,0,0);
    o[d0]=__builtin_amdgcn_mfma_f32_32x32x16_bf16(pa1,PK(1),o[d0],0,0,0);
    o[d0]=__builtin_amdgcn_mfma_f32_32x32x16_bf16(pa2,PK(2),o[d0],0,0,0);
    o[d0]=__builtin_amdgcn_mfma_f32_32x32x16_bf16(pa3,PK(3),o[d0],0,0,0);
    #undef PK
  }
}

#ifndef ATTN_STORE16
#define ATTN_STORE16(p,v) (*(u32x4*)(p)=(v))
#endif
template<int THRL> __device__ __forceinline__ void attn_unit(const bf16*Qh,const bf16*__restrict__ Kh,const bf16*__restrict__ Vh,bf16*Oh,int q0,char*shm,int tid_in){
  const int tid=tid_in,lane=tid&63,r32=lane&31,hi=lane>>5; const int wid=__builtin_amdgcn_readfirstlane(tid>>6);
  const bf16*Qw=Qh+(long)(q0+wid*QBLK)*PQ;
  const unsigned lds0=(unsigned)(uintptr_t)shm;
  float*wsf=(float*)(shm+LDS_WS)+wid*64;
  const bf16*ksrc=Kh+(long)lane*PK+wid*8;
  const bf16*vsrc=Vh+(long)(16*(wid&3)+(lane>>2))*PV+(wid>>2)*32+(lane&3)*8;
  const unsigned kdst=lds0+LDS_K+wid*1024, vdst=lds0+LDS_V+wid*1024;
  #define DMA_K(t,slot) glds16(ksrc+(long)(t)*KVBLK*PK,(unsigned)__builtin_amdgcn_readfirstlane(kdst+(slot)))
  #define DMA_V(t,slot) glds16(vsrc+(long)(t)*KVBLK*PV,(unsigned)__builtin_amdgcn_readfirstlane(vdst+(slot)))
  const int vb0=(int)(lds0+LDS_V)+((lane>>4)&1)*32+(lane&3)*8+(4*hi+((lane&15)>>2))*64;
  const char*Kbase=shm+LDS_K; bf16x8 kf[8];
  const lds_cptr shm3=(lds_cptr)shm; const lds_cptr kp0=shm3+LDS_K+hi*1024+r32*16; const lds_cptr vp0=shm3+LDS_V+((lane>>4)&1)*32+(lane&3)*8+(4*hi+((lane&15)>>2))*64;
  constexpr int NT=SEQ/KVBLK;
  DMA_K(0,0);DMA_V(0,0);DMA_K(1,SLOTB);
  bf16x8 qr[4];
  #pragma unroll
  for(int d0=0;d0<4;++d0)qr[d0]=*reinterpret_cast<const bf16x8*>(&Qw[(long)r32*PQ+d0*16+hi*8]);
  float mhat=0.f,l_reg=0.f;f32x16 o[2];o[0]=f32x16{};o[1]=f32x16{};f32x16 negm=f32x16{};asm volatile("":"+v"(negm));
  #define CMASK(P0,P1,t) do{}while(0)
  bool resc=false;
  #define START(P0,P1) do{ const float rm=rowmax(P0,P1); resc=false; \
    { const float dl=rm; mhat=fadd_s(mhat,dl); \
      _Pragma("unroll") for(int r=0;r<16;++r){P0[r]=fsub_s(P0[r],dl);P1[r]=fsub_s(P1[r],dl);} \
      _Pragma("unroll") for(int r=0;r<16;++r)negm[r]=-mhat; asm volatile("":"+v"(negm)); } \
    _Pragma("unroll") for(int r=0;r<16;++r)P0[r]=__builtin_amdgcn_exp2f(P0[r]); }while(0)
  #define RESC() do{ if(resc){ asm volatile("s_waitcnt lgkmcnt(0)":::"memory"); \
      _Pragma("unroll") for(int d_=0;d_<2;++d_) _Pragma("unroll") for(int r=0;r<16;++r)o[d_][r]*=wsf[crow(r,hi)]; } }while(0)
  f32x16 pA0,pA1,pB0,pB1;
  int sl_prev=0,sl_cur=0,sl_next=SLOTB;
  #define ROT() do{sl_prev=sl_cur;sl_cur=sl_next;sl_next=(sl_next==(NSLOT-1)*SLOTB)?0:sl_next+SLOTB;}while(0)
  DMA_K(2,2*SLOTB);
  WAIT_BAR(3);
  qkt(pA0,pA1,Kbase,qr,negm,r32,hi);asm volatile("s_nop 15\n\ts_nop 7":"+v"(pA0),"+v"(pA1));CMASK(pA0,pA1,0);
  START(pA0,pA1);
  _Pragma("unroll") for(int r=0;r<16;++r)pA1[r]=__builtin_amdgcn_exp2f(pA1[r]);
  WAIT_BAR(0);
  DMA_K(3,0);DMA_V(1,SLOTB);
  ROT();
  kload8(kf,kp0+sl_cur);
  WAIT_BAR(2);
  s16x4 vlo[8],vhi[8]; u32x4 pw0,pw1,pw2,pw3;
  #define PKW(P,B) cvtpk_s(P[B],P[B+1])
  #define PAF(k) __builtin_bit_cast(bf16x8,pw##k)
  #define VFR(i) (bf16x8){vlo[i][0],vlo[i][1],vlo[i][2],vlo[i][3],vhi[i][0],vhi[i][1],vhi[i][2],vhi[i][3]}
  #define PIN(x) asm volatile("":"+v"(x))
  #define MX3(a,b,c) __builtin_fmaxf(__builtin_fmaxf((a),(b)),(c))
  #define GAPA(MF,A0,A1,A2,A3,W0,W1,PW) do{ MF; sacc+=A0; sacc+=A1; sacc+=A2; sacc+=A3; PIN(sacc); W0; W1; PIN(PW); SBAR(); }while(0)
  #define EX(v) __builtin_amdgcn_exp2f(v)
  #define GAPB(MF,X,B) do{ MF; X[B]=EX(X[B]); X[B+1]=EX(X[B+1]); X[B+2]=EX(X[B+2]); X[B+3]=EX(X[B+3]); PIN(X); SBAR(); }while(0)
  #define VRD(i) do{ vlo[i]=vtr(vp_+(((i)>>2)*4096+((i)&3)*1024)); vhi[i]=vtr(vp_+(((i)>>2)*4096+((i)&3)*1024+512)); }while(0)
  #define KRD(G,j) do{ if(G){ kload2(kf,kp0+sl_next,j); SBAR(); } }while(0)
  #define STEP(C0,C1,P0,P1,t,GK,GV,GL) do{ SBAR(); \
    const lds_cptr vp_=vp0+sl_prev; \
    VRD(0); SBAR(); float sacc=(P0[0]+P0[1]); \
    GAPA(C0=__builtin_amdgcn_mfma_f32_32x32x16_bf16(kf[0],qr[0],negm,0,0,0), P0[2],P0[3],P0[4],P0[5],     pw0[0]=PKW(P0,0), pw0[1]=PKW(P0,2), pw0); \
    VRD(4); SBAR(); GAPA(C1=__builtin_amdgcn_mfma_f32_32x32x16_bf16(kf[1],qr[0],negm,0,0,0), P0[6],P0[7],P0[8],P0[9],     pw0[2]=PKW(P0,4), pw0[3]=PKW(P0,6), pw0); \
    VRD(1); SBAR(); GAPA(C0=__builtin_amdgcn_mfma_f32_32x32x16_bf16(kf[2],qr[1],C0,0,0,0),   P0[10],P0[11],P0[12],P0[13], pw1[0]=PKW(P0,8), pw1[1]=PKW(P0,10), pw1); \
    VRD(5); SBAR(); GAPA(C1=__builtin_amdgcn_mfma_f32_32x32x16_bf16(kf[3],qr[1],C1,0,0,0),   P0[14],P0[15],P1[0],P1[1],   pw1[2]=PKW(P0,12),pw1[3]=PKW(P0,14), pw1); \
    VRD(2); SBAR(); GAPA(C0=__builtin_amdgcn_mfma_f32_32x32x16_bf16(kf[4],qr[2],C0,0,0,0),   P1[2],P1[3],P1[4],P1[5],     pw2[0]=PKW(P1,0), pw2[1]=PKW(P1,2), pw2); \
    VRD(6); SBAR(); GAPA(C1=__builtin_amdgcn_mfma_f32_32x32x16_bf16(kf[5],qr[2],C1,0,0,0),   P1[6],P1[7],P1[8],P1[9],     pw2[2]=PKW(P1,4), pw2[3]=PKW(P1,6), pw2); \
    VRD(3); SBAR(); GAPA(C0=__builtin_amdgcn_mfma_f32_32x32x16_bf16(kf[6],qr[3],C0,0,0,0),   P1[10],P1[11],P1[12],P1[13], pw3[0]=PKW(P1,8), pw3[1]=PKW(P1,10), pw3); \
    VRD(7); SBAR(); GAPA(C1=__builtin_amdgcn_mfma_f32_32x32x16_bf16(kf[7],qr[3],C1,0,0,0),   P1[14],P1[15],0.f,0.f,       pw3[2]=PKW(P1,12),pw3[3]=PKW(P1,14), pw3); \
    l_reg+=sacc; \
    if(GK){DMA_K((t)+3,sl_cur);} if(GV){DMA_V((t)+1,sl_next);} \
    CMASK(C0,C1,t); \
    { float a=MX3(C0[0],C0[1],C1[0]),b=MX3(C0[2],C0[3],C1[1]); a=MX3(a,C1[2],C1[3]); \
      _Pragma("unroll") for(int r=4;r<16;r+=4){a=MX3(a,C0[r],C0[r+1]);b=MX3(b,C0[r+2],C0[r+3]);a=MX3(a,C1[r],C1[r+1]);b=MX3(b,C1[r+2],C1[r+3]);} \
      float rm=__builtin_fmaxf(a,b); { auto rr=__builtin_amdgcn_permlane32_swap(__float_as_uint(rm),__float_as_uint(rm),false,false); rm=__builtin_fmaxf(__uint_as_float(rr[0]),__uint_as_float(rr[1])); } \
      resc=false; \
      if(__builtin_expect(__any(rm>(float)THRL),0)){ const float dl=__builtin_fmaxf(rm,0.f); mhat+=dl; \
        _Pragma("unroll") for(int r=0;r<16;++r){C0[r]-=dl;C1[r]-=dl;} \
        _Pragma("unroll") for(int r=0;r<16;++r)negm[r]=-mhat; asm volatile("":"+v"(negm)); \
        const float f=__builtin_amdgcn_exp2f(-dl); l_reg*=f; if(hi==0)wsf[r32]=f; resc=true; } } \
    SBAR(); \
    GAPB(o[0]=__builtin_amdgcn_mfma_f32_32x32x16_bf16(PAF(0),VFR(0),o[0],0,0,0), C0,0); \
    GAPB(o[1]=__builtin_amdgcn_mfma_f32_32x32x16_bf16(PAF(0),VFR(4),o[1],0,0,0), C0,4); \
    KRD(GL,0); GAPB(o[0]=__builtin_amdgcn_mfma_f32_32x32x16_bf16(PAF(1),VFR(1),o[0],0,0,0), C0,8); \
    KRD(GL,1); GAPB(o[1]=__builtin_amdgcn_mfma_f32_32x32x16_bf16(PAF(1),VFR(5),o[1],0,0,0), C0,12); \
    KRD(GL,2); GAPB(o[0]=__builtin_amdgcn_mfma_f32_32x32x16_bf16(PAF(2),VFR(2),o[0],0,0,0), C1,0); \
    KRD(GL,3); GAPB(o[1]=__builtin_amdgcn_mfma_f32_32x32x16_bf16(PAF(2),VFR(6),o[1],0,0,0), C1,4); \
    GAPB(o[0]=__builtin_amdgcn_mfma_f32_32x32x16_bf16(PAF(3),VFR(3),o[0],0,0,0), C1,8); \
    GAPB(o[1]=__builtin_amdgcn_mfma_f32_32x32x16_bf16(PAF(3),VFR(7),o[1],0,0,0), C1,12); \
    }while(0)
  int t=1;
  #undef CMASK
  #define CMASK(P0,P1,t) do{}while(0)
  for(;t+5<NT;t+=2){
    STEP(pB0,pB1,pA0,pA1,t,true,true,true);     WAIT_BAR(2); RESC(); ROT();
    STEP(pA0,pA1,pB0,pB1,t+1,true,true,true);   WAIT_BAR(2); RESC(); ROT();
  }
  #undef CMASK
  #define CMASK(P0,P1,t) do{}while(0)
  #define ENDW(tt) do{ if((tt)+3<NT){WAIT_BAR(2);} else if((tt)+2<NT){WAIT_BAR(1);} else {WAIT_BAR(0);} }while(0)
  for(;t+1<NT;t+=2){
    STEP(pB0,pB1,pA0,pA1,t,(t+3<NT),(t+1<NT),(t+1<NT));       ENDW(t);   RESC(); ROT();
    STEP(pA0,pA1,pB0,pB1,t+1,(t+4<NT),(t+2<NT),(t+2<NT));     ENDW(t+1); RESC(); ROT();
  }
  STEP(pB0,pB1,pA0,pA1,NT-1,false,false,false); RESC();
  { float sacc=pB0[0]+pB0[1]; _Pragma("unroll") for(int r=2;r<16;++r)sacc+=pB0[r]; _Pragma("unroll") for(int r=0;r<16;++r)sacc+=pB1[r]; l_reg+=sacc;
    pw0=(u32x4){PKW(pB0,0),PKW(pB0,2),PKW(pB0,4),PKW(pB0,6)};pw1=(u32x4){PKW(pB0,8),PKW(pB0,10),PKW(pB0,12),PKW(pB0,14)};pw2=(u32x4){PKW(pB1,0),PKW(pB1,2),PKW(pB1,4),PKW(pB1,6)};pw3=(u32x4){PKW(pB1,8),PKW(pB1,10),PKW(pB1,12),PKW(pB1,14)};
    SBAR(); pv(o,vb0+sl_cur,PAF(0),PAF(1),PAF(2),PAF(3)); }
  #undef PKW
  #undef PAF
  #undef VFR
  #undef PIN
  #undef MX3
  #undef GAPA
  #undef GAPB
  #undef EX
  #undef VRD
  #undef KRD
  #undef STEP
  #undef ENDW
  {auto rr=__builtin_amdgcn_permlane32_swap(__float_as_uint(l_reg),__float_as_uint(l_reg),false,false);l_reg=__uint_as_float(rr[0])+__uint_as_float(rr[1]);}
  if(hi==0)wsf[32+r32]=l_reg;asm volatile("s_waitcnt lgkmcnt(0)":::"memory");
  float rli[16];
  #pragma unroll
  for(int r=0;r<16;++r)rli[r]=__builtin_amdgcn_rcpf(wsf[32+crow(r,hi)]);
  bf16*Ow=Oh+(long)(q0+wid*QBLK)*PO;
  { bf16*stg=(bf16*)(shm+LDS_OST)+wid*2048;
    #pragma unroll
    for(int r=0;r<16;++r){const int orow=crow(r,hi);
      #pragma unroll
      for(int d0=0;d0<2;++d0)stg[orow*64+d0*32+r32]=__float2bfloat16(o[d0][r]*rli[r]);}
    asm volatile("s_waitcnt lgkmcnt(0)":::"memory");
    #pragma unroll
    for(int i=0;i<4;++i){const int row=i*8+(lane>>3),ch=lane&7; const u32x4 v=*(const u32x4*)(stg+row*64+ch*8); ATTN_STORE16(Ow+(long)row*PO+ch*8,v);} }
  asm volatile("s_waitcnt lgkmcnt(0)\n\ts_barrier":::"memory");
  #undef DMA_K
  #undef DMA_V
  #undef CMASK
  #undef START
  #undef RESC
  #undef ROT
}
constexpr int ATTN_LDS_BYTES=LDS_BYTES;
#undef SBAR
#undef WAIT_BAR
}

namespace wattn {
using bf16x8 = __attribute__((ext_vector_type(8))) short;
using s16x4 = __attribute__((ext_vector_type(4))) short;
using f32x16 = __attribute__((ext_vector_type(16))) float;
using u32x4 = __attribute__((ext_vector_type(4))) unsigned;
typedef float f32x2_t __attribute__((ext_vector_type(2))); typedef __bf16 bf16x2_t __attribute__((ext_vector_type(2)));
__device__ __forceinline__ unsigned cvtpk(float lo, float hi) { f32x2_t v = {lo, hi}; bf16x2_t b = __builtin_convertvector(v, bf16x2_t); return __builtin_bit_cast(unsigned, b); }
__device__ __forceinline__ int crow(int r, int hi) { return (r & 3) + 8 * (r >> 2) + 4 * hi; }
typedef __attribute__((address_space(3))) char* lds_ptr;
typedef short v4i16_t __attribute__((ext_vector_type(4)));
__device__ __forceinline__ s16x4 vtr(lds_ptr p) { return __builtin_bit_cast(s16x4, __builtin_amdgcn_ds_read_tr16_b64_v4i16((__attribute__((address_space(3))) v4i16_t*)p)); }
template <class Desc> __device__ __forceinline__ void wave_attn(const Desc& ds, lds_ptr wl, int lane) {
    typedef __attribute__((address_space(3))) u32x4 lds_u32x4; typedef __attribute__((address_space(3))) bf16x8 lds_bf16x8;
    const int r32 = lane & 31, hi = lane >> 5, lrow = lane >> 3, lch = lane & 7;
    bf16x8 qf[4];
    { const unsigned short* qp = ds.qptr(r32);
#pragma unroll
      for (int d0 = 0; d0 < 4; ++d0) qf[d0] = *(const bf16x8*)(qp + 16 * d0 + 8 * hi); }
    f32x16 o0, o1;
#pragma unroll
    for (int r = 0; r < 16; ++r) { o0[r] = 0.f; o1[r] = 0.f; }
    float l = 0.f; const float off = ds.off;
    const int nt = ds.ntiles();
    u32x4 kA[4], vA[4], kB[4], vB[4];
#define WATTN_LOAD(KX, VX, T) do { _Pragma("unroll") for (int i = 0; i < 4; ++i) { const unsigned short* p_ = ds.row_ptr((T), lrow + 8 * i) + lch * 8; KX[i] = *(const u32x4*)p_; VX[i] = *(const u32x4*)(p_ + Desc::VOFF); } } while (0)
    WATTN_LOAD(kA, vA, 0); if (nt > 1) WATTN_LOAD(kB, vB, 1);
    const lds_ptr kw = wl + lrow * 144 + lch * 16, vw = wl + 4608 + lrow * 128 + lch * 16;
    const lds_ptr kr = wl + r32 * 144 + hi * 16;
    const lds_ptr vr = wl + 4608 + (4 * hi + ((lane & 15) >> 2)) * 128 + ((lane >> 4) & 1) * 32 + (lane & 3) * 8;
#define WATTN_STEP(KX, VX, T) do { const int t = (T); \
        asm volatile("" ::: "memory"); \
        _Pragma("unroll") for (int i = 0; i < 4; ++i) { *(lds_u32x4*)(kw + 1152 * i) = KX[i]; *(lds_u32x4*)(vw + 1024 * i) = VX[i]; } \
        asm volatile("" ::: "memory"); \
        if (t + 2 < nt) WATTN_LOAD(KX, VX, t + 2); \
        bf16x8 kf[4]; \
        _Pragma("unroll") for (int d0 = 0; d0 < 4; ++d0) kf[d0] = *(const lds_bf16x8*)(kr + 32 * d0); \
        f32x16 p; \
        _Pragma("unroll") for (int r = 0; r < 16; ++r) p[r] = -off; \
        _Pragma("unroll") for (int d0 = 0; d0 < 4; ++d0) p = __builtin_amdgcn_mfma_f32_32x32x16_bf16(kf[d0], qf[d0], p, 0, 0, 0); \
        int lo, hb; ds.bounds(t, r32, lo, hb); \
        if (Desc::HAS_BIAS) { const __attribute__((address_space(3))) float* bb = ds.bias_base(t, r32) + 4 * hi; \
            _Pragma("unroll") for (int r = 0; r < 16; ++r) p[r] += bb[(r & 3) + 8 * (r >> 2)]; } \
        if (!__all(lo <= 0 && hb >= 31)) { const unsigned w = (unsigned)(hb - lo); const int dd = 4 * hi - lo; \
            _Pragma("unroll") for (int r = 0; r < 16; ++r) p[r] = ((unsigned)((r & 3) + 8 * (r >> 2) + dd) <= w) ? p[r] : -INFINITY; } \
        { float rs = 0.f; \
          _Pragma("unroll") for (int r = 0; r < 16; ++r) { p[r] = __builtin_amdgcn_exp2f(p[r]); rs += p[r]; } \
          rs += __shfl_xor(rs, 32); l += rs; } \
        u32x4 pw0, pw1; \
        pw0 = (u32x4){cvtpk(p[0], p[1]), cvtpk(p[2], p[3]), cvtpk(p[4], p[5]), cvtpk(p[6], p[7])}; \
        pw1 = (u32x4){cvtpk(p[8], p[9]), cvtpk(p[10], p[11]), cvtpk(p[12], p[13]), cvtpk(p[14], p[15])}; \
        const bf16x8 pa0 = __builtin_bit_cast(bf16x8, pw0), pa1 = __builtin_bit_cast(bf16x8, pw1); \
        _Pragma("unroll") for (int s = 0; s < 2; ++s) { \
            _Pragma("unroll") for (int dh = 0; dh < 2; ++dh) { \
                const s16x4 lo4 = vtr(vr + (16 * s) * 128 + dh * 64), hh = vtr(vr + (16 * s + 8) * 128 + dh * 64); \
                const bf16x8 vf = (bf16x8){lo4[0], lo4[1], lo4[2], lo4[3], hh[0], hh[1], hh[2], hh[3]}; \
                if (dh == 0) o0 = __builtin_amdgcn_mfma_f32_32x32x16_bf16(s == 0 ? pa0 : pa1, vf, o0, 0, 0, 0); \
                else o1 = __builtin_amdgcn_mfma_f32_32x32x16_bf16(s == 0 ? pa0 : pa1, vf, o1, 0, 0, 0); \
            } } \
        asm volatile("" ::: "memory"); } while (0)
    for (int tt = 0; tt < nt; tt += 2) {
        WATTN_STEP(kA, vA, tt);
        if (tt + 1 < nt) WATTN_STEP(kB, vB, tt + 1);
    }
#undef WATTN_STEP
#undef WATTN_LOAD
    const float rl = 1.0f / l; const lds_ptr ow = wl + 4608;
    int hi_e = hi, r32_e = r32; asm volatile("" : "+v"(hi_e), "+v"(r32_e));
    asm volatile("" ::: "memory");
#pragma unroll
    for (int r = 0; r < 16; ++r) { const int qi = crow(r, hi_e); const float a = __shfl(rl, qi);
        *(__attribute__((address_space(3))) unsigned short*)(ow + qi * 128 + r32_e * 2) = (unsigned short)(cvtpk(o0[r] * a, 0.f) & 0xffffu);
        *(__attribute__((address_space(3))) unsigned short*)(ow + qi * 128 + 64 + r32_e * 2) = (unsigned short)(cvtpk(o1[r] * a, 0.f) & 0xffffu); }
    asm volatile("" ::: "memory");
#pragma unroll
    for (int i = 0; i < 4; ++i) { const int row = lrow + 8 * i;
        const u32x4 w = *(const lds_u32x4*)(ow + row * 128 + lch * 16); ds.store16(row, lch, w); }
    if (hi == 0) ds.lse(r32, (off + __builtin_amdgcn_logf(l)) * 0.6931471805599453f);
    asm volatile("" ::: "memory");
}
}
namespace dattn {
using bf16x8 = __attribute__((ext_vector_type(8))) short;
using s16x4  = __attribute__((ext_vector_type(4))) short;
using f32x16 = __attribute__((ext_vector_type(16))) float;
using u32x4  = __attribute__((ext_vector_type(4))) unsigned;
typedef unsigned short bf16r;
constexpr int NW = 8, QBLK = 32, KVBLK = 64, SEQ = 2048, DQK = 64, DV = 128;
constexpr int SHM_V = KVBLK * DV * 2, SHM_K = KVBLK * DQK * 2, OFF_K = 2 * SHM_V, OFF_WS = OFF_K + 2 * SHM_K, OFF_STASH = OFF_WS + NW * 64 * 4, LDS_BYTES = OFF_STASH + 256 * DV * 2;
constexpr float THRL = 8.f;
#define DA_KSWZ(row, colB) ((row) * 128 + ((colB) ^ (((row) & 7) << 4)))
#define DA_SBAR() __builtin_amdgcn_sched_barrier(0)
__device__ __forceinline__ int crow(int r, int hi) { return (r & 3) + 8 * (r >> 2) + 4 * hi; }
__device__ __forceinline__ int opqv(int v) { asm volatile("" : "+v"(v)); return v; }
__device__ __forceinline__ unsigned cvtpk(float lo, float hi) { unsigned r; asm volatile("v_cvt_pk_bf16_f32 %0, %1, %2" : "=v"(r) : "v"(lo), "v"(hi)); return r; }
__device__ __forceinline__ void partialSM(f32x16& p0) {
#pragma unroll
  for (int r = 0; r < 16; ++r) p0[r] = __builtin_amdgcn_exp2f(p0[r]);
}
__device__ __forceinline__ void finishSM(f32x16& p0, f32x16& p1, float& l_reg, bf16x8& pa0, bf16x8& pa1, bf16x8& pa2, bf16x8& pa3) {
#pragma unroll
  for (int r = 0; r < 16; ++r) p1[r] = __builtin_amdgcn_exp2f(p1[r]);
  typedef float f32x2_ __attribute__((ext_vector_type(2)));
  f32x2_ s2 = {0.f, 0.f};
#pragma unroll
  for (int r = 0; r < 16; r += 2) { s2 += (f32x2_){p0[r], p0[r + 1]}; s2 += (f32x2_){p1[r], p1[r + 1]}; }
  float ps = s2.x + s2.y;
  { auto rr = __builtin_amdgcn_permlane32_swap(__float_as_uint(ps), __float_as_uint(ps), false, false);
    ps = __uint_as_float(rr[0]) + __uint_as_float(rr[1]); }
  l_reg += ps;
#define DA_PK4(P, BASE, OUT) do { unsigned a0 = cvtpk(P[BASE + 0], P[BASE + 1]), a1 = cvtpk(P[BASE + 2], P[BASE + 3]);   \
    unsigned b0 = cvtpk(P[BASE + 4], P[BASE + 5]), b1 = cvtpk(P[BASE + 6], P[BASE + 7]);                              \
    auto r0 = __builtin_amdgcn_permlane32_swap(a0, b0, false, false); auto r1 = __builtin_amdgcn_permlane32_swap(a1, b1, false, false); \
    u32x4 w = {r0[0], r1[0], r0[1], r1[1]}; OUT = *reinterpret_cast<bf16x8*>(&w); } while (0)
  DA_PK4(p0, 0, pa0); DA_PK4(p0, 8, pa1); DA_PK4(p1, 0, pa2); DA_PK4(p1, 8, pa3);
#undef DA_PK4
}
__device__ __forceinline__ void qkt(f32x16& p0, f32x16& p1, const char* Ks, const bf16x8* qr, int r32, int hi, const f32x16& negoff) {
  p0 = negoff; p1 = negoff;
#pragma unroll
  for (int d0 = 0; d0 < 4; ++d0) { const int cb = (d0 * 16 + hi * 8) * 2;
    bf16x8 b0 = *reinterpret_cast<const bf16x8*>(Ks + DA_KSWZ(r32, cb));
    bf16x8 b1 = *reinterpret_cast<const bf16x8*>(Ks + DA_KSWZ(32 + r32, cb));
    p0 = __builtin_amdgcn_mfma_f32_32x32x16_bf16(b0, qr[d0], p0, 0, 0, 0);
    p1 = __builtin_amdgcn_mfma_f32_32x32x16_bf16(b1, qr[d0], p1, 0, 0, 0); }
}
__device__ __forceinline__ int v_st(int k, int c) { const int kk = (k & ~0xC) | ((k & 4) << 1) | ((k & 8) >> 1); return ((kk >> 3) * 4 + (c >> 5)) * 512 + ((kk & 7) * 32 + (c & 31)) * 2; }
__device__ __forceinline__ int v_rd_base(int lane) { return ((lane & 3) << 3) | (((lane >> 2) & 3) << 6) | (((lane >> 4) & 1) << 5) | (((lane >> 5) & 1) << 8); }
constexpr int v_rd_off(int d0, int ks, int half) { return d0 * 512 + ks * 4096 + half * 2048; }
template <int OFF> __device__ __forceinline__ s16x4 tr_read(int vb) { s16x4 r; asm volatile("ds_read_b64_tr_b16 %0, %1 offset:%2" : "=&v"(r) : "v"(vb), "i"(OFF) : "memory"); return r; }
template <int D0> __device__ __forceinline__ void pv_one(f32x16& od, int vb, bf16x8 pa0, bf16x8 pa1, bf16x8 pa2, bf16x8 pa3) {
  const s16x4 l0 = tr_read<v_rd_off(D0, 0, 0)>(vb), h0 = tr_read<v_rd_off(D0, 0, 1)>(vb), l1 = tr_read<v_rd_off(D0, 1, 0)>(vb), h1 = tr_read<v_rd_off(D0, 1, 1)>(vb);
  const s16x4 l2 = tr_read<v_rd_off(D0, 2, 0)>(vb), h2 = tr_read<v_rd_off(D0, 2, 1)>(vb), l3 = tr_read<v_rd_off(D0, 3, 0)>(vb), h3 = tr_read<v_rd_off(D0, 3, 1)>(vb);
  asm volatile("s_waitcnt lgkmcnt(0)" ::: "memory"); DA_SBAR();
#define DA_PK(L, H) (bf16x8){L[0], L[1], L[2], L[3], H[0], H[1], H[2], H[3]}
  od = __builtin_amdgcn_mfma_f32_32x32x16_bf16(pa0, DA_PK(l0, h0), od, 0, 0, 0);
  od = __builtin_amdgcn_mfma_f32_32x32x16_bf16(pa1, DA_PK(l1, h1), od, 0, 0, 0);
  od = __builtin_amdgcn_mfma_f32_32x32x16_bf16(pa2, DA_PK(l2, h2), od, 0, 0, 0);
  od = __builtin_amdgcn_mfma_f32_32x32x16_bf16(pa3, DA_PK(l3, h3), od, 0, 0, 0);
#undef DA_PK
}
__device__ __forceinline__ void pv_d0(f32x16* o, int vb, bf16x8 pa0, bf16x8 pa1, bf16x8 pa2, bf16x8 pa3) {
  pv_one<0>(o[0], vb, pa0, pa1, pa2, pa3); pv_one<1>(o[1], vb, pa0, pa1, pa2, pa3); pv_one<2>(o[2], vb, pa0, pa1, pa2, pa3); pv_one<3>(o[3], vb, pa0, pa1, pa2, pa3);
}
__device__ __forceinline__ void flash_pass(const bf16r* __restrict__ Qb, const bf16r* __restrict__ Kh, const bf16r* __restrict__ Vh, char* lds, int tid, float off, f32x16 (&o)[4], float& l_reg) {
  tid = opqv(tid);
  const int wid = __builtin_amdgcn_readfirstlane(tid >> 6), lane = tid & 63, r32 = lane & 31, hi = lane >> 5;
  char* V_lds = lds; char* K_lds = lds + OFF_K;
  l_reg = 0.f; f32x16 negoff;
#pragma unroll
  for (int r = 0; r < 16; ++r) negoff[r] = -off;
  asm volatile("" : "+v"(negoff));
#pragma unroll
  for (int d = 0; d < 4; ++d) o[d] = f32x16{};
  bf16x8 qr[4];
  const bf16r* Qw = Qb + (long)(wid * QBLK + r32) * DQK + hi * 8;
#pragma unroll
  for (int d0 = 0; d0 < 4; ++d0) qr[d0] = *reinterpret_cast<const bf16x8*>(Qw + d0 * 16);
  const int sr = tid >> 4, sc = (tid & 15) * 8, vst0 = v_st(sr, sc), vst1 = v_st(32 + sr, sc);
  const int kr = tid >> 3, kc = (tid & 7) * 8, kst = DA_KSWZ(kr, kc * 2);
  const int vb0 = (int)(uintptr_t)V_lds + v_rd_base(lane);
  struct { bf16x8 vs0, vs1, ks; } sr_[2];
#define DA_SLOAD(i, k0) do { sr_[i].vs0 = *reinterpret_cast<const bf16x8*>(&Vh[(long)((k0) + sr) * DV + sc]); sr_[i].vs1 = *reinterpret_cast<const bf16x8*>(&Vh[(long)((k0) + 32 + sr) * DV + sc]); \
    sr_[i].ks = *reinterpret_cast<const bf16x8*>(&Kh[(long)((k0) + kr) * DQK + kc]); } while (0)
#define DA_SWRITE(b, i) do { *(bf16x8*)(V_lds + (b) * SHM_V + vst0) = sr_[i].vs0; *(bf16x8*)(V_lds + (b) * SHM_V + vst1) = sr_[i].vs1; *(bf16x8*)(K_lds + (b) * SHM_K + kst) = sr_[i].ks; } while (0)
#define DA_SWAIT() asm volatile("s_waitcnt vmcnt(3)" ::: "memory")
  f32x16 pA0, pA1, pB0, pB1; bf16x8 pa0, pa1, pa2, pa3; constexpr int NT = SEQ / KVBLK;
  constexpr int SE = 0, SO = 1;
  DA_SLOAD(SE, 0); asm volatile("s_waitcnt vmcnt(0)" ::: "memory"); DA_SWRITE(0, SE); __syncthreads();
  qkt(pA0, pA1, K_lds, qr, r32, hi, negoff); partialSM(pA0);
  DA_SLOAD(SO, KVBLK); DA_SLOAD(SE, 2 * KVBLK);
  DA_SWAIT(); DA_SWRITE(1, SO); __syncthreads();
  for (int j = 1; j + 1 < NT; j += 2) {
    DA_SBAR(); qkt(pB0, pB1, K_lds + SHM_K, qr, r32, hi, negoff);
    finishSM(pA0, pA1, l_reg, pa0, pa1, pa2, pa3); DA_SBAR();
    DA_SLOAD(SO, (j + 2) * KVBLK); DA_SBAR();
    pv_d0(o, vb0, pa0, pa1, pa2, pa3); partialSM(pB0);
    __syncthreads(); DA_SWAIT(); DA_SWRITE(0, SE);
    __syncthreads();
    DA_SBAR(); qkt(pA0, pA1, K_lds, qr, r32, hi, negoff);
    finishSM(pB0, pB1, l_reg, pa0, pa1, pa2, pa3); DA_SBAR();
    if (j + 3 < NT) DA_SLOAD(SE, (j + 3) * KVBLK); DA_SBAR();
    pv_d0(o, vb0 + SHM_V, pa0, pa1, pa2, pa3); partialSM(pA0);
    __syncthreads(); DA_SWAIT(); DA_SWRITE(1, SO);
    __syncthreads();
  }
  DA_SBAR(); qkt(pB0, pB1, K_lds + SHM_K, qr, r32, hi, negoff);
  finishSM(pA0, pA1, l_reg, pa0, pa1, pa2, pa3); DA_SBAR();
  pv_d0(o, vb0, pa0, pa1, pa2, pa3); partialSM(pB0);
  __syncthreads();
  finishSM(pB0, pB1, l_reg, pa0, pa1, pa2, pa3); DA_SBAR();
  pv_d0(o, vb0 + SHM_V, pa0, pa1, pa2, pa3);
#undef DA_SLOAD
#undef DA_SWRITE
#undef DA_SWAIT
}
__device__ __forceinline__ void diff_unit(const bf16r* Qt, const bf16r* Kt, const bf16r* Vt, bf16r* OB, int b, int h8, int q0, float lam, const float* sub_g, float osc, float eps, float off, char* lds, int tid) {
  const int wid = __builtin_amdgcn_readfirstlane(tid >> 6), lane = tid & 63;
  float* ws = (float*)(lds + OFF_WS) + wid * 64; float* li_l = ws;
  char* stash = lds + OFF_STASH + wid * (QBLK * DV * 2);
  f32x16 o[4]; float l_reg;
  const bf16r* Vh = Vt + ((long)(b * 8 + h8) * SEQ) * DV;
  flash_pass(Qt + ((long)(b * 16 + 2 * h8) * SEQ + q0) * DQK, Kt + ((long)(b * 16 + 2 * h8) * SEQ) * DQK, Vh, lds, tid, off, o, l_reg);
  { const int lane_ = opqv(lane), r32 = lane_ & 31, hi = lane_ >> 5;
    if (hi == 0) li_l[r32] = l_reg; asm volatile("s_waitcnt lgkmcnt(0)" ::: "memory");
#pragma unroll
    for (int r = 0; r < 16; ++r) { const int q = crow(r, hi); const float rl = __builtin_amdgcn_rcpf(li_l[q]);
#pragma unroll
      for (int d0 = 0; d0 < 4; ++d0) *(bf16r*)(stash + (q * DV + d0 * 32 + r32) * 2) = (bf16r)(cvtpk(o[d0][r] * rl, 0.f) & 0xffffu); } }
  asm volatile("s_waitcnt lgkmcnt(0)" ::: "memory");
  flash_pass(Qt + ((long)(b * 16 + 2 * h8 + 1) * SEQ + q0) * DQK, Kt + ((long)(b * 16 + 2 * h8 + 1) * SEQ) * DQK, Vh, lds, tid, off, o, l_reg);
  { const int lane_ = opqv(lane), r32 = lane_ & 31, hi = lane_ >> 5;
    if (hi == 0) li_l[r32] = l_reg; asm volatile("s_waitcnt lgkmcnt(0)" ::: "memory");
    float sg[4];
#pragma unroll
    for (int d0 = 0; d0 < 4; ++d0) sg[d0] = sub_g[d0 * 32 + r32] * osc;
#pragma unroll
    for (int r = 0; r < 16; ++r) { const int q = crow(r, hi); const float rl = __builtin_amdgcn_rcpf(li_l[q]) * lam; float od[4]; float ss = 0.f;
#pragma unroll
      for (int d0 = 0; d0 < 4; ++d0) { const unsigned s0 = *(const bf16r*)(stash + (q * DV + d0 * 32 + r32) * 2); od[d0] = __uint_as_float(s0 << 16) - o[d0][r] * rl; ss += od[d0] * od[d0]; }
#pragma unroll
      for (int x = 1; x < 32; x <<= 1) ss += __shfl_xor(ss, x);
      const float rstd = 1.0f / sqrtf(ss * (1.f / DV) + eps);
#pragma unroll
      for (int d0 = 0; d0 < 4; ++d0) *(bf16r*)(stash + (q * DV + d0 * 32 + r32) * 2) = (bf16r)(cvtpk(od[d0] * rstd * sg[d0], 0.f) & 0xffffu); }
    asm volatile("s_waitcnt lgkmcnt(0)" ::: "memory");
    bf16r* Ow = OB + ((long)(b * SEQ + q0 + wid * QBLK)) * 1024 + h8 * DV;
#pragma unroll
    for (int i = 0; i < 8; ++i) { const int row = (lane_ >> 4) + 4 * i, ch = lane_ & 15;
      const u32x4 w = *(const u32x4*)(stash + row * (DV * 2) + ch * 16); *(u32x4*)(Ow + (long)row * 1024 + ch * 8) = w; } }
  asm volatile("s_waitcnt lgkmcnt(0)" ::: "memory");
}
#undef DA_KSWZ
#undef DA_SBAR
}
constexpr int NWAVES = 8;
constexpr int BATCH = 16, SEQ = 2048, D = 1024, M = BATCH * SEQ, NH = 16, HD = 64, NE = 16, CAP = 256, DFF = 2048, NSLOT = BATCH * NE * CAP, NLAYER = 4;
constexpr float EPS = 1e-6f;
constexpr int N_IN = 28;
enum { I_X = 0, I_GMIX, I_GFFN, I_NA_WQKV, I_NA_QN, I_NA_KN, I_NA_RPB, I_NA_WOUT, I_DF_WQKV, I_DF_QN, I_DF_KN, I_DF_LQ1, I_DF_LK1, I_DF_LQ2, I_DF_LK2, I_DF_SUB, I_DF_WOUT,
       I_SC_WIN, I_SC_CONV, I_SC_WOUT, I_DL_WQKV, I_DL_QN, I_DL_KN, I_DL_WOUT, I_ROUTER, I_WGATE, I_WUP, I_WDOWN };
constexpr size_t MiB = 1u << 20;
constexpr size_t WS_CTL = 0, CTL_ZERO_BYTES = 1 * MiB;
constexpr size_t WS_AFFT = 2 * MiB;
constexpr size_t WS_IDX = 4 * MiB;
constexpr size_t WS_GATE = 4 * MiB + 512 * 1024;
constexpr size_t WS_SLOTOF = 6 * MiB;
constexpr size_t WS_LSE = 8 * MiB;
constexpr size_t WS_ROPE = 15 * MiB;
constexpr size_t WS_WQKV = 16 * MiB;
constexpr size_t WS_WOUT = 52 * MiB;
constexpr size_t WS_WGU = 64 * MiB;
constexpr size_t WS_WDN = 576 * MiB;
constexpr size_t WS_HN8 = 704 * MiB;
constexpr size_t WS_HN = 832 * MiB;
constexpr size_t WS_QKV = 896 * MiB;
constexpr size_t WS_XIN = 896 * MiB;
constexpr size_t WS_HMID = 1024 * MiB;
constexpr size_t WS_Y = 1280 * MiB;
constexpr size_t WS_O = 1472 * MiB;
constexpr size_t WS_OG = 1536 * MiB;
constexpr size_t WS_MIX = WS_OG;
constexpr size_t WS_XB = 1792 * MiB;
constexpr size_t WS_END = 1856 * MiB;
__host__ __device__ constexpr size_t wqkv_off(int L) { return WS_WQKV + (size_t)L * 6 * MiB; }
constexpr int CW_TMO = 0, CW_CODE = 1, CW_BAR = 4096;
constexpr int RING_OFF = 0, RING_BYTES = 131072;
constexpr int LDSCTL_OFF = RING_BYTES, MISC_OFF = LDSCTL_OFF + 320;
constexpr int LDS_BYTES = 147456;

struct Args { const float* in[N_IN]; float* out; unsigned char* ws; int ph_lo, ph_hi, li, pad; };
struct Frame {
    LAS unsigned char* lds;
    volatile LAS unsigned* MISC;
    gu32* ctl;
    int tid, lane, wave, vcu, G, gw, NGW;
    float* out; unsigned char* ws;
};
__device__ __forceinline__ int opq(int v) { asm volatile("" : "+v"(v)); return v; }
__device__ __forceinline__ int opq_s(int v) { asm volatile("" : "+s"(v)); return v; }
__device__ __forceinline__ Frame make_frame(const Args& args, unsigned char* lds_generic, int wave_s) {
    Frame F;
    F.lds = (LAS unsigned char*)lds_generic;
    F.MISC = (volatile LAS unsigned*)(F.lds + MISC_OFF);
    F.wave = opq_s(wave_s); F.lane = opq((int)__builtin_amdgcn_mbcnt_hi(~0u, __builtin_amdgcn_mbcnt_lo(~0u, 0u))); F.tid = F.wave * 64 + F.lane;
    F.G = opq_s((int)gridDim.x); { const int bx = opq_s((int)blockIdx.x); F.vcu = (F.G % 8 == 0) ? (bx % 8) * (F.G / 8) + bx / 8 : bx; }
    F.gw = F.vcu * NWAVES + F.wave; F.NGW = F.G * NWAVES;
    F.out = args.out; F.ws = args.ws;
    F.ctl = (gu32*)(args.ws + WS_CTL);
    return F;
}
__device__ __forceinline__ XcdBarrier make_bar(const Args& args, unsigned char* lds_generic) {
    XcdBarrier b; b.bar = (unsigned*)((gu32*)(args.ws + WS_CTL) + CW_BAR) + args.li * XCD_BAR_WORDS; b.x = xb_xcc_id(); b.st = (volatile LAS unsigned*)((LAS unsigned char*)lds_generic + MISC_OFF) + 8; return b;
}
__device__ __forceinline__ float wave_sum(float v) {
#pragma unroll
    for (int o = 1; o < 64; o <<= 1) v += __shfl_xor(v, o);
    return v;
}
__device__ __forceinline__ float bflo(unsigned u) { return __uint_as_float(u << 16); }
__device__ __forceinline__ float bfhi(unsigned u) { return __uint_as_float(u & 0xffff0000u); }
__device__ __forceinline__ void unpack8(const v4u w, float (&x)[8]) { x[0] = bflo(w.x); x[1] = bfhi(w.x); x[2] = bflo(w.y); x[3] = bfhi(w.y); x[4] = bflo(w.z); x[5] = bfhi(w.z); x[6] = bflo(w.w); x[7] = bfhi(w.w); }
__device__ __forceinline__ v4u pack8(const float (&x)[8]) { v4u w; w.x = pk2(x[0], x[1]); w.y = pk2(x[2], x[3]); w.z = pk2(x[4], x[5]); w.w = pk2(x[6], x[7]); return w; }

template <bool F32> struct XRow;
template <> struct XRow<true> { f32x4 r[4];
    __device__ __forceinline__ void load(const void* base, int m, int lane) { const GAS f32x4* xr = (const GAS f32x4*)((const float*)base + (size_t)m * D) + lane;
#pragma unroll
        for (int j = 0; j < 4; ++j) r[j] = xr[64 * j]; }
    __device__ __forceinline__ void get(f32x4 (&v)[4]) const {
#pragma unroll
        for (int j = 0; j < 4; ++j) v[j] = r[j]; } };
template <> struct XRow<false> { unsigned long long r[4];
    __device__ __forceinline__ void load(const void* base, int m, int lane) { const GAS unsigned long long* xr = (const GAS unsigned long long*)((const bf16*)base + (size_t)m * D) + lane;
#pragma unroll
        for (int j = 0; j < 4; ++j) r[j] = xr[64 * j]; }
    __device__ __forceinline__ void get(f32x4 (&v)[4]) const {
#pragma unroll
        for (int j = 0; j < 4; ++j) { const unsigned lo_ = (unsigned)r[j], hi_ = (unsigned)(r[j] >> 32); v[j] = (f32x4){bflo(lo_), bfhi(lo_), bflo(hi_), bfhi(hi_)}; } } };
__device__ __forceinline__ void add_bf16_row(f32x4 (&v)[4], const unsigned long long (&mv)[4]) {
#pragma unroll
    for (int j = 0; j < 4; ++j) { const unsigned lo_ = (unsigned)mv[j], hi_ = (unsigned)(mv[j] >> 32); v[j].x += bflo(lo_); v[j].y += bfhi(lo_); v[j].z += bflo(hi_); v[j].w += bfhi(hi_); }
}
__device__ __forceinline__ void tr_item(const float* srcl, size_t ldn, int k0, bf16* WT, int K, int drow0, LAS float* scr, int lane) {
#pragma unroll 8
    for (int i = 0; i < 32; ++i) { const int kk = 2 * i + (lane >> 5); scr[kk * 33 + (lane & 31)] = srcl[(size_t)(k0 + kk) * ldn]; }
    LDS_WAIT(); asm volatile("" ::: "memory");
    const int c = lane & 7;
#pragma unroll
    for (int j = 0; j < 4; ++j) { const int n = (lane >> 3) + 8 * j; const LAS float* s = scr + (8 * c) * 33 + n;
        v4u o; o.x = pk2(s[0 * 33], s[1 * 33]); o.y = pk2(s[2 * 33], s[3 * 33]); o.z = pk2(s[4 * 33], s[5 * 33]); o.w = pk2(s[6 * 33], s[7 * 33]);
        *(GAS v4u*)(WT + (size_t)(drow0 + n) * K + k0 + 8 * c) = o; }
    LDS_WAIT(); asm volatile("" ::: "memory");
}
typedef unsigned v2u __attribute__((ext_vector_type(2)));
__device__ __forceinline__ void tr_item8(const float* srcl, size_t ldn, int k0, unsigned char* WT, int K, int drow0, float sc, LAS float* scr, int lane) {
#pragma unroll 8
    for (int i = 0; i < 32; ++i) { const int kk = 2 * i + (lane >> 5); scr[kk * 33 + (lane & 31)] = srcl[(size_t)(k0 + kk) * ldn]; }
    LDS_WAIT(); asm volatile("" ::: "memory");
    const int c = lane & 7;
#pragma unroll
    for (int j = 0; j < 4; ++j) { const int n = (lane >> 3) + 8 * j; const LAS float* s = scr + (8 * c) * 33 + n;
        v2u o; o.x = pg8::pk4_fp8(s[0 * 33] * sc, s[1 * 33] * sc, s[2 * 33] * sc, s[3 * 33] * sc); o.y = pg8::pk4_fp8(s[4 * 33] * sc, s[5 * 33] * sc, s[6 * 33] * sc, s[7 * 33] * sc);
        *(GAS v2u*)(WT + (size_t)(drow0 + n) * K + k0 + 8 * c) = o; }
    LDS_WAIT(); asm volatile("" ::: "memory");
}
struct CvtDesc { const float* srcl; unsigned char* WT; size_t ldn; int k0, K, drow0, prow; };
__device__ __forceinline__ void cvt8_load(const CvtDesc& d, f32x4 (&v)[16], int lane) {
    const int r = lane >> 3;
#pragma unroll
    for (int i = 0; i < 4; ++i)
#pragma unroll
        for (int j = 0; j < 4; ++j) v[4 * i + j] = *(const GAS f32x4*)(d.srcl + (size_t)(d.k0 + 32 * i + 4 * r + j) * d.ldn);
}
__device__ __forceinline__ void cvt8_finish(const CvtDesc& d, const f32x4 (&v)[16], float sc, LAS unsigned char* scr, int lane) {
    const int r = lane >> 3;
#pragma unroll
    for (int i = 0; i < 4; ++i)
#pragma unroll
        for (int e = 0; e < 4; ++e)
            *(LAS unsigned*)(scr + (d.prow + e) * 144 + 32 * i + 4 * r) = pg8::pk4_fp8(v[4 * i][e] * sc, v[4 * i + 1][e] * sc, v[4 * i + 2][e] * sc, v[4 * i + 3][e] * sc);
    LDS_WAIT(); asm volatile("" ::: "memory");
#pragma unroll
    for (int q = 0; q < 4; ++q) { const int row = r + 8 * q, ch = lane & 7;
        const v4u w = *(const LAS v4u*)(scr + row * 144 + ch * 16);
        *(GAS v4u*)(d.WT + (size_t)(d.drow0 + row) * d.K + d.k0 + ch * 16) = w; }
    LDS_WAIT(); asm volatile("" ::: "memory");
}
__device__ __forceinline__ void cvtb_load(const CvtDesc& d, f32x4 (&v)[16], int wave) {
#pragma unroll
    for (int a = 0; a < 4; ++a)
#pragma unroll
        for (int j = 0; j < 4; ++j) v[4 * a + j] = *(const GAS f32x4*)(d.srcl + (size_t)(d.k0 + 16 * wave + 4 * a + j) * d.ldn);
}
__device__ __forceinline__ void cvtb_pack(const CvtDesc& d, const f32x4 (&v)[16], float sc, LAS unsigned char* tile, int wave) {
#pragma unroll
    for (int a = 0; a < 4; ++a)
#pragma unroll
        for (int e = 0; e < 4; ++e)
            *(LAS unsigned*)(tile + (d.prow + e) * 132 + 16 * wave + 4 * a) = pg8::pk4_fp8(v[4 * a][e] * sc, v[4 * a + 1][e] * sc, v[4 * a + 2][e] * sc, v[4 * a + 3][e] * sc);
}
__device__ __forceinline__ void cvtb_out(const CvtDesc& d, LAS const unsigned char* tile, int wave, int lane) {
#pragma unroll
    for (int q = 0; q < 4; ++q) { const int row = 32 * wave + (lane >> 3) + 8 * q, ch = lane & 7; const LAS unsigned* s = (const LAS unsigned*)(tile + row * 132 + ch * 16);
        v4u w; w.x = s[0]; w.y = s[1]; w.z = s[2]; w.w = s[3];
        *(GAS v4u*)(d.WT + (size_t)(d.drow0 + row) * d.K + d.k0 + ch * 16) = w; }
}
__device__ __forceinline__ void cvtb_pack16(const CvtDesc& d, const f32x4 (&v)[16], LAS unsigned char* tile, int wave) {
#pragma unroll
    for (int a = 0; a < 4; ++a)
#pragma unroll
        for (int e = 0; e < 4; ++e) { LAS unsigned* p = (LAS unsigned*)(tile + (d.prow + e) * 260 + (16 * wave + 4 * a) * 2);
            p[0] = pk2(v[4 * a][e], v[4 * a + 1][e]); p[1] = pk2(v[4 * a + 2][e], v[4 * a + 3][e]); }
}
__device__ __forceinline__ void cvtb_out16(const CvtDesc& d, LAS const unsigned char* tile, int wave, int lane) {
#pragma unroll
    for (int q = 0; q < 8; ++q) { const int row = 32 * wave + (lane >> 4) + 4 * q, ch = lane & 15; const LAS unsigned* s = (const LAS unsigned*)(tile + row * 260 + ch * 16);
        v4u w; w.x = s[0]; w.y = s[1]; w.z = s[2]; w.w = s[3];
        *(GAS v4u*)(d.WT + ((size_t)(d.drow0 + row) * d.K + d.k0) * 2 + ch * 16) = w; }
}
__device__ __forceinline__ void tr_plain(const float* W, int K, int N, bf16* WT, int item, LAS float* scr, int lane) {
    const int nblk = N / 32, kb = item / nblk, nb = item % nblk;
    tr_item(W + 32 * nb + (lane & 31), (size_t)N, 64 * kb, WT, K, 32 * nb, scr, lane);
}
__device__ __forceinline__ void tr_qkv(const float* W, int K, int N, bf16* WT, int item, LAS float* scr, int lane) {
    const int nblk = N / 32, kb = item / nblk, nb = item % nblk, n0 = 32 * nb;
    tr_item(W + n0 + (lane & 31), (size_t)N, 64 * kb, WT, K, (n0 & ~255) + 128 * ((n0 >> 5) & 1) + 32 * ((n0 >> 6) & 3), scr, lane);
}
__device__ __forceinline__ void rms_apply(f32x4 (&v)[4], const f32x4 (&gg)[4]) {
    float s = 0.f;
#pragma unroll
    for (int j = 0; j < 4; ++j) s += (v[j].x * v[j].x + v[j].y * v[j].y) + (v[j].z * v[j].z + v[j].w * v[j].w);
    const float rstd = 1.0f / sqrtf(wave_sum(s) * (1.f / D) + EPS);
#pragma unroll
    for (int j = 0; j < 4; ++j) v[j] = v[j] * rstd * gg[j];
}
__device__ __forceinline__ void store_row_bf16(bf16* orow, int lane, const f32x4 (&v)[4]) {
    GAS unsigned long long* o8 = (GAS unsigned long long*)orow + lane;
#pragma unroll
    for (int j = 0; j < 4; ++j) o8[64 * j] = (unsigned long long)pk2(v[j].x, v[j].y) | ((unsigned long long)pk2(v[j].z, v[j].w) << 32);
}
__device__ __forceinline__ void p0_prologue(Frame& F, const Args& A) {
    LAS float* scr = (LAS float*)(F.lds + RING_OFF + F.wave * 16384);
    const float* wgate = A.in[I_WGATE]; const float* wup = A.in[I_WUP]; const float* wdown = A.in[I_WDOWN];
    unsigned char* WGU = (unsigned char*)(F.ws + WS_WGU); unsigned char* WDN = (unsigned char*)(F.ws + WS_WDN);
    constexpr int B_GU = 64 * 128, B_DN = 64 * 64, B_Q3 = 8 * 36, B_O3 = 8 * 4, NB8 = B_GU + B_DN + B_Q3 + B_O3;
    const int lane = F.lane, wave = F.wave;
    const float* wqkv3 = A.in[I_DL_WQKV]; unsigned char* WQ3 = (unsigned char*)(F.ws + wqkv_off(3)); const float* wout3 = A.in[I_DL_WOUT]; unsigned char* WO3 = (unsigned char*)(F.ws + WS_WOUT + 3 * 2 * MiB);
    LAS unsigned char* tile = (LAS unsigned char*)(F.lds + RING_OFF);
#define CVT_DECODE(IT, DD) do { int r_ = (IT); \
        if (r_ < B_GU) { const int le = r_ >> 7, rr = r_ & 127, kb = rr >> 4, nb = rr & 15, n0 = 256 * nb, up_ = lane >> 5, l_ = lane & 31;     \
            DD.srcl = (up_ ? wup : wgate) + (size_t)le * (1024 * 2048) + (n0 >> 1) + 4 * l_; DD.ldn = 2048; DD.k0 = 128 * kb; DD.WT = WGU + (size_t)le * (4096 * 1024); DD.K = 1024; DD.drow0 = n0; DD.prow = 4 * l_ + 128 * up_; } \
        else if (r_ < B_GU + B_DN) { r_ -= B_GU; const int le = r_ >> 6, rr = r_ & 63, kb = rr >> 2, nb = rr & 3;                                \
            DD.srcl = wdown + (size_t)le * (2048 * 1024) + 256 * nb + 4 * lane; DD.ldn = 1024; DD.k0 = 128 * kb; DD.WT = WDN + (size_t)le * (1024 * 2048); DD.K = 2048; DD.drow0 = 256 * nb; DD.prow = 4 * lane; } \
        else if (r_ < B_GU + B_DN + B_Q3) { r_ -= B_GU + B_DN; const int kb = r_ / 36, nb = r_ % 36, hw_ = lane >> 4, bj_ = (lane >> 3) & 1, j4_ = lane & 7;     \
            DD.srcl = wqkv3 + 256 * nb + 4 * lane; DD.ldn = 9216; DD.k0 = 128 * kb; DD.WT = WQ3; DD.K = 1024; DD.drow0 = 256 * nb; DD.prow = 128 * bj_ + 32 * hw_ + 4 * j4_; } \
        else { r_ -= B_GU + B_DN + B_Q3; const int kb = r_ >> 2, nb = r_ & 3;                                                                      \
            DD.srcl = wout3 + 256 * nb + 4 * lane; DD.ldn = 1024; DD.k0 = 128 * kb; DD.WT = WO3; DD.K = 1024; DD.drow0 = 256 * nb; DD.prow = 4 * lane; } } while (0)
    { CvtDesc dA, dB; f32x4 vA[16], vB[16]; int it = F.vcu;
      if (it < NB8) { CVT_DECODE(it, dA); cvtb_load(dA, vA, wave); }
      while (it < NB8) {
          const int i1 = it + F.G, i2 = it + 2 * F.G;
          if (i1 < NB8) { CVT_DECODE(i1, dB); cvtb_load(dB, vB, wave); }
          cvtb_pack(dA, vA, 256.f, tile, wave); __syncthreads(); cvtb_out(dA, tile, wave, lane); __syncthreads();
          if (i1 >= NB8) break;
          if (i2 < NB8) { CVT_DECODE(i2, dA); cvtb_load(dA, vA, wave); }
          cvtb_pack(dB, vB, 256.f, tile, wave); __syncthreads(); cvtb_out(dB, tile, wave, lane); __syncthreads();
          it = i2; } }
#undef CVT_DECODE
    { constexpr int B_Q = 8 * 12, B_O = 8 * 4, NB16 = 3 * B_Q + 3 * B_O;
      for (int it = F.vcu; it < NB16; it += F.G) { CvtDesc dd; f32x4 vv[16]; int r_ = it;
          if (r_ < 3 * B_Q) { const int which = r_ / B_Q, rr = r_ % B_Q, kb = rr / 12, nb = rr % 12, hw_ = lane >> 4, bj_ = (lane >> 3) & 1, j4_ = lane & 7;
              const float* W = (which == 0) ? A.in[I_NA_WQKV] : (which == 1) ? A.in[I_DF_WQKV] : A.in[I_SC_WIN];
              dd.srcl = W + 256 * nb + 4 * lane; dd.ldn = 3072; dd.k0 = 128 * kb; dd.WT = (unsigned char*)(F.ws + wqkv_off(which)); dd.K = 1024; dd.drow0 = 256 * nb; dd.prow = 128 * bj_ + 32 * hw_ + 4 * j4_; }
          else { r_ -= 3 * B_Q; const int which = r_ / B_O, rr = r_ % B_O, kb = rr >> 2, nb = rr & 3;
              const float* W = (which == 0) ? A.in[I_NA_WOUT] : (which == 1) ? A.in[I_DF_WOUT] : A.in[I_SC_WOUT];
              dd.srcl = W + 256 * nb + 4 * lane; dd.ldn = 1024; dd.k0 = 128 * kb; dd.WT = (unsigned char*)(F.ws + WS_WOUT + (size_t)which * 2 * MiB); dd.K = 1024; dd.drow0 = 256 * nb; dd.prow = 4 * lane; }
          cvtb_load(dd, vv, wave); cvtb_pack16(dd, vv, tile, wave); __syncthreads(); cvtb_out16(dd, tile, wave, lane); __syncthreads(); } }
    { float2* rope = (float2*)(F.ws + WS_ROPE);
      for (int idx = blockIdx.x * (NWAVES * 64) + opq(F.tid); idx < SEQ * 32; idx += F.G * NWAVES * 64) { const int pos = idx >> 5, j = idx & 31;
          const float invf = exp2f(-(float)j * 0.41524101186092029f); const float af = (float)pos * invf;
          const double a = (double)af; const double n = rint(a * 0.15915494309189535); const float rf = (float)(a - n * 6.283185307179586);
          rope[idx] = make_float2(__cosf(rf), __sinf(rf)); } }
    { const float* g = A.in[I_GMIX]; f32x4 gg[4];
#pragma unroll
      for (int j = 0; j < 4; ++j) gg[j] = ((const GAS f32x4*)g)[lane + 64 * j];
      bf16* HN = (bf16*)(F.ws + WS_HN); const float* x = A.in[I_X];
      XRow<true> xc, xn; xc.load(x, F.gw, lane);
      for (int m = F.gw; m < M; m += F.NGW) { const int mn = (m + F.NGW < M) ? m + F.NGW : m; xn.load(x, mn, lane);
          f32x4 v[4]; xc.get(v); rms_apply(v, gg); store_row_bf16(HN + (size_t)m * D, lane, v); xc = xn; } }
}

__device__ __forceinline__ void prep_phase(Frame& F, bf16* buf, int ld, int ng, const float* qg, const float* kg, bool use_rope, float qscale) {
    const int lane = opq(F.lane), c = lane & 7, nch = 4 * ng; const long total = (long)M * nch;
    const float2* rope = (const float2*)(F.ws + WS_ROPE);
    float gq[8], gk[8];
#pragma unroll
    for (int i = 0; i < 8; ++i) { gq[i] = qg[c * 8 + i]; gk[i] = kg[c * 8 + i]; }
    for (long it = F.gw; it < total; it += F.NGW) {
        const int tok = (int)(it / nch), ch = (int)(it % nch), g = ch >> 2, part = (ch >> 1) & 1, half = ch & 1;
        bf16* p = buf + (size_t)tok * ld + g * 3072 + part * 1024 + half * 512 + lane * 8;
        const v4u w = *(const GAS v4u*)p; float x[8]; unpack8(w, x);
        float ss = 0.f;
#pragma unroll
        for (int i = 0; i < 8; ++i) ss += x[i] * x[i];
        ss += __shfl_xor(ss, 1); ss += __shfl_xor(ss, 2); ss += __shfl_xor(ss, 4);
        const float rstd = 1.0f / sqrtf(ss * (1.f / 64.f) + EPS);
        float y[8];
#pragma unroll
        for (int i = 0; i < 8; ++i) y[i] = x[i] * rstd * (part ? gk[i] : gq[i]);
        if (use_rope) { const int pos = tok & (SEQ - 1); const float2* rp = rope + pos * 32 + 8 * (c & 3);
#pragma unroll
            for (int i = 0; i < 8; ++i) { const float py = __shfl_xor(y[i], 4); const float2 cs = rp[i];
                y[i] = (c < 4) ? (y[i] * cs.x - py * cs.y) : (y[i] * cs.x + py * cs.y); } }
        if (part == 0) {
#pragma unroll
            for (int i = 0; i < 8; ++i) y[i] *= qscale; }
        *(GAS v4u*)p = pack8(y);
    }
}

__device__ __forceinline__ void diff_attn_phase(Frame& F, const bf16* QKV, bf16* OC, char* lds_generic) {
    for (int i = 0;; ++i) { const int Lu = i * F.G + F.vcu; if (Lu >= BATCH * 32 * 8) break;
        const int qb = Lu & 7, hp = (Lu >> 3) & 31, b = Lu >> 8, h8 = hp >> 2, c = (hp >> 1) & 1, vh = hp & 1;
        constexpr size_t TEN = (size_t)32 << 20;
        attn_body::attn_unit<8>((const attn_body::bf16*)(QKV + ((size_t)(b * 16 + 2 * h8 + c) * SEQ) * 64), (const attn_body::bf16*)(QKV + TEN + ((size_t)(b * 16 + 2 * h8 + c) * SEQ) * 64),
                                (const attn_body::bf16*)(QKV + 2 * TEN + ((size_t)(b * 8 + h8) * SEQ) * 128 + vh * 64),
                                (attn_body::bf16*)(OC + ((size_t)c * M + (size_t)b * SEQ) * D + h8 * 128 + vh * 64), qb * 256, lds_generic, F.tid); }
}
__device__ __forceinline__ void diff_combine(Frame& F, const Args& A, const bf16* OC, bf16* O, float lambda_init) {
    const int lane = opq(F.lane);
    const float d1 = wave_sum(A.in[I_DF_LQ1][lane] * A.in[I_DF_LK1][lane]), d2 = wave_sum(A.in[I_DF_LQ2][lane] * A.in[I_DF_LK2][lane]);
    const float lam = expf(d1) - expf(d2) + lambda_init;
    float sg[16];
#pragma unroll
    for (int i = 0; i < 16; ++i) sg[i] = A.in[I_DF_SUB][(lane & 7) * 16 + i] * (1.0f - lambda_init);
    for (int m = F.gw; m < M; m += F.NGW) {
        const GAS v4u* a = (const GAS v4u*)(OC + (size_t)m * D + lane * 16); const GAS v4u* bq = (const GAS v4u*)(OC + ((size_t)M + m) * D + lane * 16);
        float o[16]; float ss = 0.f;
#pragma unroll
        for (int i = 0; i < 2; ++i) { float x[8], y[8]; unpack8(a[i], x); unpack8(bq[i], y);
#pragma unroll
            for (int e = 0; e < 8; ++e) { const float v = x[e] - lam * y[e]; o[8 * i + e] = v; ss += v * v; } }
        ss += __shfl_xor(ss, 1); ss += __shfl_xor(ss, 2); ss += __shfl_xor(ss, 4);
        const float rstd = 1.0f / sqrtf(ss * (1.f / 128.f) + EPS);
        float t0[8], t1[8];
#pragma unroll
        for (int i = 0; i < 8; ++i) { t0[i] = o[i] * rstd * sg[i]; t1[i] = o[8 + i] * rstd * sg[8 + i]; }
        GAS v4u* op = (GAS v4u*)(O + (size_t)m * D + lane * 16); op[0] = pack8(t0); op[1] = pack8(t1);
    }
}
__device__ __forceinline__ void diff_attn_phase2(Frame& F, const Args& A, const bf16* QKV, bf16* OB, float lambda_init, char* lds_generic) {
    const int lane = opq(F.lane);
    const float d1 = wave_sum(A.in[I_DF_LQ1][lane] * A.in[I_DF_LK1][lane]), d2 = wave_sum(A.in[I_DF_LQ2][lane] * A.in[I_DF_LK2][lane]);
    const float lam = expf(d1) - expf(d2) + lambda_init;
    float gqm = fabsf(A.in[I_DF_QN][lane]), gkm = fabsf(A.in[I_DF_KN][lane]);
#pragma unroll
    for (int o_ = 1; o_ < 64; o_ <<= 1) { gqm = fmaxf(gqm, __shfl_xor(gqm, o_)); gkm = fmaxf(gkm, __shfl_xor(gkm, o_)); }
    const float off = fminf(8.0f * 1.4426950408889634f * gqm * gkm * 1.02f, 60.0f);
    constexpr size_t TEN = (size_t)32 << 20;
    for (int i = 0;; ++i) { const int Lu = i * F.G + F.vcu; if (Lu >= BATCH * 8 * 8) break;
        const int qb = Lu & 7, h8 = (Lu >> 3) & 7, b = Lu >> 6;
        dattn::diff_unit(QKV, QKV + TEN, QKV + 2 * TEN, OB, b, h8, qb * 256, lam, A.in[I_DF_SUB], 1.0f - lambda_init, EPS, off, lds_generic, F.tid); }
}
struct NaDesc {
    static constexpr bool HAS_BIAS = true;
    const bf16* QKV; const LAS float* rpb; bf16* O; int b, h, r, cb, R0, w0; float off;
    __device__ __forceinline__ int ntiles() const { return 9; }
    __device__ __forceinline__ size_t qtok(int qi) const { return (size_t)(b * SEQ + (r + (qi >> 4)) * 64 + 16 * cb + (qi & 15)); }
    static constexpr int VOFF = 32 << 20;
    __device__ __forceinline__ const bf16* qptr(int qi) const { return QKV + ((size_t)(b * 16 + h) * SEQ + (r + (qi >> 4)) * 64 + 16 * cb + (qi & 15)) * 64; }
    __device__ __forceinline__ const bf16* row_ptr(int t, int row) const { const int kr = min(R0 + t, 31); return QKV + (size_t)VOFF + ((size_t)(b * 16 + h) * SEQ + kr * 64 + w0 + row) * 64; }
    __device__ __forceinline__ void bounds(int t, int qi, int& lo, int& hb) const {
        const int qrow = r + (qi >> 4), qc = 16 * cb + (qi & 15), kr = R0 + t, r0q = min(max(qrow - 4, 0), 24), csq = min(max(qc - 8, 0), 48);
        const bool row_ok = (kr >= r0q) && (kr < r0q + 8);
        lo = row_ok ? csq - w0 : 64; hb = row_ok ? csq - w0 + 15 : 64; }
    __device__ __forceinline__ const LAS float* bias_base(int t, int qi) const { const int qrow = r + (qi >> 4), qc = 16 * cb + (qi & 15); return rpb + (R0 + t - qrow + 7) * 31 + (w0 - qc + 15); }
    __device__ __forceinline__ void store16(int qi, int ch, wattn::u32x4 v) const { *(GAS wattn::u32x4*)(O + qtok(qi) * D + h * 64 + 8 * ch) = v; }
    __device__ __forceinline__ void lse(int, float) const {}
};
__device__ __forceinline__ void na_attn_phase(Frame& F, const bf16* QKV, const float* rpb, bf16* O, const float* qg, const float* kg) {
    const int lane = opq(F.lane); const wattn::lds_ptr wl = (wattn::lds_ptr)(F.lds + RING_OFF + F.wave * 10752);
    LAS float* bl = (LAS float*)(F.lds + RING_OFF + F.wave * 10752 + 8704); int hcur = -1; float off = 0.f;
    float gqm = fabsf(qg[lane]), gkm = fabsf(kg[lane]);
#pragma unroll
    for (int o_ = 1; o_ < 64; o_ <<= 1) { gqm = fmaxf(gqm, __shfl_xor(gqm, o_)); gkm = fmaxf(gkm, __shfl_xor(gkm, o_)); }
    const float qkb = 8.0f * 1.4426950408889634f * gqm * gkm * 1.02f;
    for (int it = F.gw; it < BATCH * NH * 16 * 4; it += F.NGW) {
        { const int hn_ = (it >> 6) & 15;
          if (hn_ != hcur) { hcur = hn_; asm volatile("" ::: "memory"); float bm = 0.f;
              for (int i = lane; i < 15 * 31; i += 64) { const float v_ = rpb[hn_ * 15 * 31 + i] * 1.4426950408889634f; bl[i] = v_; bm = fmaxf(bm, fabsf(v_)); }
#pragma unroll
              for (int o_ = 1; o_ < 64; o_ <<= 1) bm = fmaxf(bm, __shfl_xor(bm, o_));
              off = fminf(qkb + bm, 60.0f); LDS_WAIT(); asm volatile("" ::: "memory"); } }
        NaDesc ds; ds.QKV = QKV; ds.rpb = bl; ds.O = O; ds.off = off; ds.cb = it & 3; ds.r = 2 * ((it >> 2) & 15); ds.h = (it >> 6) & 15; ds.b = it >> 10;
        ds.R0 = min(max(ds.r - 4, 0), 24); ds.w0 = (ds.cb == 0) ? 0 : (ds.cb == 1) ? 8 : (ds.cb == 2) ? 24 : 32;
        wattn::wave_attn(ds, wl, lane); }
}
struct DilDesc {
    static constexpr bool HAS_BIAS = false;
    const bf16* QKV; bf16* OG; float* LSE; int g, b, h, rho, j0, dsh, Lsub; float off;
    __device__ __forceinline__ int ntiles() const { return 5; }
    __device__ __forceinline__ size_t qtok(int qi) const { return (size_t)(b * SEQ + ((j0 + qi) << dsh) + rho); }
    static constexpr int VOFF = 32 << 20;
    __device__ __forceinline__ const bf16* qptr(int qi) const { return QKV + (size_t)(3 * g) * VOFF + ((size_t)(b * 16 + h) * SEQ + rho * Lsub + j0 + qi) * 64; }
    __device__ __forceinline__ const bf16* row_ptr(int t, int row) const { const int jk = min(max(j0 - 64 + 32 * t + row, 0), Lsub - 1); return QKV + (size_t)(3 * g + 1) * VOFF + ((size_t)(b * 16 + h) * SEQ + rho * Lsub + jk) * 64; }
    __device__ __forceinline__ void bounds(int t, int qi, int& lo, int& hb) const { const int jq = j0 + qi, base = j0 - 64 + 32 * t; lo = max(0, jq - 64) - base; hb = min(Lsub - 1, jq + 64) - base; }
    __device__ __forceinline__ const LAS float* bias_base(int, int) const { return nullptr; }
    __device__ __forceinline__ void store16(int qi, int ch, wattn::u32x4 v) const { *(GAS wattn::u32x4*)(OG + ((size_t)g * M + qtok(qi)) * D + h * 64 + 8 * ch) = v; }
    __device__ __forceinline__ void lse(int qi, float v) const { LSE[((size_t)g * M + qtok(qi)) * 16 + h] = v; }
};
__device__ __forceinline__ void dil_attn_phase(Frame& F, const bf16* QKV, bf16* OG, float* LSE) {
    const int lane = opq(F.lane); const wattn::lds_ptr wl = (wattn::lds_ptr)(F.lds + RING_OFF + F.wave * 10752);
    for (int it = F.gw; it < 3 * BATCH * NH * 64; it += F.NGW) {
        DilDesc ds; ds.QKV = QKV; ds.OG = OG; ds.LSE = LSE; const int sub = it & 63; ds.h = (it >> 6) & 15; ds.b = (it >> 10) & 15; ds.g = it >> 14;
        ds.dsh = 2 * ds.g; ds.Lsub = SEQ >> ds.dsh; const int nb = ds.Lsub >> 5; ds.rho = sub / nb; ds.j0 = 32 * (sub % nb);
        wattn::wave_attn(ds, wl, lane); }
}
__device__ __forceinline__ void conv_naive(Frame& F, const bf16* QKV, const float* cw, bf16* O) {
    const int lane = opq(F.lane);
    float w0[16], w1[16], w2[16];
#pragma unroll
    for (int i = 0; i < 16; ++i) { w0[i] = cw[lane * 16 + i]; w1[i] = cw[1024 + lane * 16 + i]; w2[i] = cw[2048 + lane * 16 + i]; }
    for (int m = F.gw; m < M; m += F.NGW) {
        const int s = m & (SEQ - 1);
        float acc[16];
#pragma unroll
        for (int i = 0; i < 16; ++i) acc[i] = 0.f;
#pragma unroll
        for (int w = 0; w < 3; ++w) { const int ss = s + w - 1; if (ss < 0 || ss >= SEQ) continue;
            const bf16* row = QKV + (size_t)(m + w - 1) * 3072 + lane * 16;
#pragma unroll
            for (int hf = 0; hf < 2; ++hf) { float cc[8], uu[8]; unpack8(*(const GAS v4u*)(row + 1024 + hf * 8), cc); unpack8(*(const GAS v4u*)(row + 2048 + hf * 8), uu);
#pragma unroll
                for (int e = 0; e < 8; ++e) { const float z = cc[e] * uu[e]; const float wv = (w == 0) ? w0[hf * 8 + e] : (w == 1) ? w1[hf * 8 + e] : w2[hf * 8 + e]; acc[hf * 8 + e] += wv * z; } } }
        const bf16* row = QKV + (size_t)m * 3072 + lane * 16;
#pragma unroll
        for (int hf = 0; hf < 2; ++hf) { float bb[8], t[8]; unpack8(*(const GAS v4u*)(row + hf * 8), bb);
#pragma unroll
            for (int e = 0; e < 8; ++e) t[e] = bb[e] * acc[hf * 8 + e];
            *(GAS v4u*)(O + (size_t)m * D + lane * 16 + hf * 8) = pack8(t); }
    }
}
__device__ __forceinline__ wattn::u32x4 w8(const v2u w) {
    typedef float f2_ __attribute__((ext_vector_type(2)));
    const f2_ a = __builtin_amdgcn_cvt_pk_f32_fp8((int)w.x, false) * 0.0625f, b = __builtin_amdgcn_cvt_pk_f32_fp8((int)w.x, true) * 0.0625f, c = __builtin_amdgcn_cvt_pk_f32_fp8((int)w.y, false) * 0.0625f, d = __builtin_amdgcn_cvt_pk_f32_fp8((int)w.y, true) * 0.0625f;
    return (wattn::u32x4){wattn::cvtpk(a.x, a.y), wattn::cvtpk(b.x, b.y), wattn::cvtpk(c.x, c.y), wattn::cvtpk(d.x, d.y)};
}
__device__ __forceinline__ void dil_attn_coop(Frame& F, const bf16* QKV, bf16* OG, float* LSE, const float* qg, const float* kg) {
    typedef __attribute__((address_space(3))) wattn::u32x4 lds_u32x4; typedef __attribute__((address_space(3))) wattn::bf16x8 lds_bf16x8;
    using wattn::crow; using wattn::cvtpk; using wattn::vtr; using wattn::f32x16; using wattn::bf16x8; using wattn::s16x4; using wattn::u32x4;
    constexpr int SLOT = 8704, VOFF = 32 << 20, NUNITS = 3 * BATCH * NH * 8;
    const int lane = opq(F.lane), wave = F.wave, r32 = lane & 31, hi = lane >> 5, lrow = lane >> 3, lch = lane & 7;
    const wattn::lds_ptr base = (wattn::lds_ptr)(F.lds + RING_OFF);
#define DU_DECODE(U, P) const int P##x = (U) & 7, P##h = ((U) >> 3) & 15, P##b = ((U) >> 7) & 15, P##g = (U) >> 11, P##dsh = 2 * P##g, P##Ls = SEQ >> P##dsh, P##nres = (P##g == 2) ? 2 : 1, P##qpr = (P##g == 2) ? 128 : 256, \
        P##rho0 = (P##g == 0) ? 0 : (P##g == 1) ? (P##x >> 1) : 2 * P##x, P##j0 = (P##g == 0) ? 256 * P##x : (P##g == 1) ? 256 * (P##x & 1) : 0, \
        P##kt0 = max(0, (P##j0 >> 5) - 2), P##kt1 = min((P##Ls >> 5) - 1, (P##j0 >> 5) + (P##qpr >> 5) + 1), P##nkt = P##kt1 - P##kt0 + 1, P##nsl = P##nres * P##nkt; \
        const unsigned char* P##Kt = (const unsigned char*)QKV + (size_t)(3 * P##g + 1) * VOFF + ((size_t)(P##b * 16 + P##h) * SEQ) * 64
    v2u tl[12], qn[4];
    float gqm = fabsf(qg[lane]), gkm = fabsf(kg[lane]);
#pragma unroll
    for (int o_ = 1; o_ < 64; o_ <<= 1) { gqm = fmaxf(gqm, __shfl_xor(gqm, o_)); gkm = fmaxf(gkm, __shfl_xor(gkm, o_)); }
    const float off = fminf(8.0f * 1.4426950408889634f * gqm * gkm * 1.02f, 60.0f);
#define DU_LOAD(P) do { _Pragma("unroll") for (int s = 0; s < 12; ++s) if (s < P##nsl) { const int r_ = (s >= P##nkt) ? 1 : 0, kt_ = P##kt0 + ((s >= P##nkt) ? s - P##nkt : s), row_ = 8 * (wave & 3) + lrow;   \
            const unsigned char* p_ = P##Kt + ((size_t)((P##rho0 + r_) * P##Ls + kt_ * 32 + row_)) * 64 + lch * 8 + ((wave >= 4) ? VOFF : 0); tl[s] = *(const v2u*)p_; } \
        { const int res_ = (P##g == 2) ? (wave >> 2) : 0, wq_ = (P##g == 2) ? (wave & 3) : wave; const unsigned char* qp_ = (const unsigned char*)QKV + (size_t)(3 * P##g) * VOFF + ((size_t)(P##b * 16 + P##h) * SEQ + (P##rho0 + res_) * P##Ls + P##j0 + 32 * wq_ + r32) * 64; \
          _Pragma("unroll") for (int d0 = 0; d0 < 4; ++d0) qn[d0] = *(const v2u*)(qp_ + 16 * d0 + 8 * hi); } } while (0)
#define DU_WRITE(P) do { _Pragma("unroll") for (int s = 0; s < 12; ++s) if (s < P##nsl) { const int row_ = 8 * (wave & 3) + lrow; \
            *(lds_u32x4*)(base + s * SLOT + ((wave >= 4) ? (4608 + row_ * 128) : (row_ * 144)) + lch * 16) = w8(tl[s]); } } while (0)
    int u = F.vcu;
    if (u >= NUNITS) return;
    { DU_DECODE(u, c); DU_LOAD(c); DU_WRITE(c); }
    bf16x8 qf[4];
#pragma unroll
    for (int d0 = 0; d0 < 4; ++d0) qf[d0] = __builtin_bit_cast(bf16x8, w8(qn[d0]));
    __syncthreads();
    for (; u < NUNITS; u += F.G) {
        DU_DECODE(u, c);
        const int un = u + F.G; const bool has_next = un < NUNITS;
        if (has_next) { DU_DECODE(un, n); DU_LOAD(n); }
        const int res = (cg == 2) ? (wave >> 2) : 0, wq = (cg == 2) ? (wave & 3) : wave, jq0 = cj0 + 32 * wq;
        f32x16 o0, o1; float l = 0.f;
#pragma unroll
        for (int r = 0; r < 16; ++r) { o0[r] = 0.f; o1[r] = 0.f; }
        for (int t = 0; t < 5; ++t) {
            const int kt = (jq0 >> 5) - 2 + t; if (kt < 0 || kt >= (cLs >> 5)) continue;
            const wattn::lds_ptr sb = base + (res * cnkt + kt - ckt0) * SLOT;
            bf16x8 kf[4];
#pragma unroll
            for (int d0 = 0; d0 < 4; ++d0) kf[d0] = *(const lds_bf16x8*)(sb + r32 * 144 + hi * 16 + 32 * d0);
            f32x16 p;
#pragma unroll
            for (int r = 0; r < 16; ++r) p[r] = -off;
#pragma unroll
            for (int d0 = 0; d0 < 4; ++d0) p = __builtin_amdgcn_mfma_f32_32x32x16_bf16(kf[d0], qf[d0], p, 0, 0, 0);
            const int jq = jq0 + r32, kb = kt * 32, lo = max(0, jq - 64) - kb, hb = min(cLs - 1, jq + 64) - kb;
            if (!__all(lo <= 0 && hb >= 31)) { const unsigned w = (unsigned)(hb - lo); const int dd = 4 * hi - lo;
#pragma unroll
                for (int r = 0; r < 16; ++r) p[r] = ((unsigned)((r & 3) + 8 * (r >> 2) + dd) <= w) ? p[r] : -INFINITY; }
            { typedef float f32x2_ __attribute__((ext_vector_type(2))); f32x2_ s2 = {0.f, 0.f};
#pragma unroll
              for (int r = 0; r < 16; ++r) p[r] = __builtin_amdgcn_exp2f(p[r]);
#pragma unroll
              for (int r = 0; r < 16; r += 2) s2 += (f32x2_){p[r], p[r + 1]};
              float rs = s2.x + s2.y; rs += __shfl_xor(rs, 32); l += rs; }
            const u32x4 pw0 = (u32x4){cvtpk(p[0], p[1]), cvtpk(p[2], p[3]), cvtpk(p[4], p[5]), cvtpk(p[6], p[7])};
            const u32x4 pw1 = (u32x4){cvtpk(p[8], p[9]), cvtpk(p[10], p[11]), cvtpk(p[12], p[13]), cvtpk(p[14], p[15])};
            const bf16x8 pa0 = __builtin_bit_cast(bf16x8, pw0), pa1 = __builtin_bit_cast(bf16x8, pw1);
            const wattn::lds_ptr vr = sb + 4608 + (4 * hi + ((lane & 15) >> 2)) * 128 + ((lane >> 4) & 1) * 32 + (lane & 3) * 8;
#pragma unroll
            for (int s = 0; s < 2; ++s) {
#pragma unroll
                for (int dh = 0; dh < 2; ++dh) {
                    const s16x4 lo4 = vtr(vr + (16 * s) * 128 + dh * 64), hh = vtr(vr + (16 * s + 8) * 128 + dh * 64);
                    const bf16x8 vf = (bf16x8){lo4[0], lo4[1], lo4[2], lo4[3], hh[0], hh[1], hh[2], hh[3]};
                    if (dh == 0) o0 = __builtin_amdgcn_mfma_f32_32x32x16_bf16(s == 0 ? pa0 : pa1, vf, o0, 0, 0, 0);
                    else o1 = __builtin_amdgcn_mfma_f32_32x32x16_bf16(s == 0 ? pa0 : pa1, vf, o1, 0, 0, 0);
                } }
        }
        __syncthreads();
        { const wattn::lds_ptr ow = base + wave * SLOT + 4608; const float rl = 32.0f / l;
          asm volatile("" ::: "memory");
#pragma unroll
          for (int r = 0; r < 16; ++r) { const int qi = crow(r, hi); const float a_ = __shfl(rl, qi);
              { const int w2_ = __builtin_amdgcn_cvt_pk_fp8_f32(__builtin_amdgcn_fmed3f(o0[r] * a_, -448.f, 448.f), __builtin_amdgcn_fmed3f(o1[r] * a_, -448.f, 448.f), 0, false);
                *(__attribute__((address_space(3))) unsigned char*)(ow + qi * 64 + r32) = (unsigned char)(w2_ & 0xff); *(__attribute__((address_space(3))) unsigned char*)(ow + qi * 64 + 32 + r32) = (unsigned char)((w2_ >> 8) & 0xff); } }
          asm volatile("" ::: "memory");
          const size_t tok0 = (size_t)cb * SEQ + crho0 + res;
#pragma unroll
          for (int i = 0; i < 2; ++i) { const int row = (lane >> 2) + 16 * i, c4 = lane & 3; const u32x4 w = *(const lds_u32x4*)(ow + row * 64 + c4 * 16);
              *(GAS u32x4*)((unsigned char*)OG + ((size_t)cg * M + tok0 + ((size_t)(jq0 + row) << cdsh)) * D + ch * 64 + 16 * c4) = w; }
          if (hi == 0) LSE[((size_t)cg * M + tok0 + ((size_t)(jq0 + r32) << cdsh)) * 16 + ch] = (off + __builtin_amdgcn_logf(l)) * 0.6931471805599453f;
          asm volatile("" ::: "memory"); }
        __syncthreads();
        if (has_next) { DU_DECODE(un, n); DU_WRITE(n);
#pragma unroll
            for (int d0 = 0; d0 < 4; ++d0) qf[d0] = __builtin_bit_cast(bf16x8, w8(qn[d0])); }
        __syncthreads();
    }
#undef DU_WRITE
#undef DU_LOAD
#undef DU_DECODE
}
__device__ __forceinline__ void dil_merge(Frame& F, const unsigned char* OG8, const float* LSE, unsigned char* O8) {
    const int lane = opq(F.lane), h = lane >> 2; typedef float f2_ __attribute__((ext_vector_type(2)));
    for (int m = F.gw; m < M; m += F.NGW) {
        const float l0 = LSE[(size_t)m * 16 + h], l1 = LSE[((size_t)M + m) * 16 + h], l2 = LSE[((size_t)2 * M + m) * 16 + h];
        const float mx = fmaxf(l0, fmaxf(l1, l2)); float a0 = __expf(l0 - mx), a1 = __expf(l1 - mx), a2 = __expf(l2 - mx); const float rs = 0.5f / (a0 + a1 + a2); a0 *= rs; a1 *= rs; a2 *= rs;
        const v4u x0 = *(const GAS v4u*)(OG8 + (size_t)m * D + lane * 16), x1 = *(const GAS v4u*)(OG8 + ((size_t)M + m) * D + lane * 16), x2 = *(const GAS v4u*)(OG8 + ((size_t)2 * M + m) * D + lane * 16);
        v4u o;
#pragma unroll
        for (int w = 0; w < 4; ++w) { const f2_ p0 = __builtin_amdgcn_cvt_pk_f32_fp8((int)x0[w], false), p1 = __builtin_amdgcn_cvt_pk_f32_fp8((int)x0[w], true), q0 = __builtin_amdgcn_cvt_pk_f32_fp8((int)x1[w], false), q1 = __builtin_amdgcn_cvt_pk_f32_fp8((int)x1[w], true),
                r0 = __builtin_amdgcn_cvt_pk_f32_fp8((int)x2[w], false), r1 = __builtin_amdgcn_cvt_pk_f32_fp8((int)x2[w], true);
            o[w] = pg8::pk4_fp8(a0 * p0.x + a1 * q0.x + a2 * r0.x, a0 * p0.y + a1 * q0.y + a2 * r0.y, a0 * p1.x + a1 * q1.x + a2 * r1.x, a0 * p1.y + a1 * q1.y + a2 * r1.y); }
        *(GAS v4u*)(O8 + (size_t)m * D + lane * 16) = o;
    }
}

__device__ __forceinline__ void router_finish(float (&a)[16], const int lane, const int m, float* AFFT) {
    { const bool h = (lane & 32) != 0;
#pragma unroll
      for (int e = 0; e < 8; ++e) { const float send = h ? a[e] : a[e + 8], keep = h ? a[e + 8] : a[e]; a[e] = keep + __shfl_xor(send, 32); } }
    { const bool h = (lane & 16) != 0;
#pragma unroll
      for (int e = 0; e < 4; ++e) { const float send = h ? a[e] : a[e + 4], keep = h ? a[e + 4] : a[e]; a[e] = keep + __shfl_xor(send, 16); } }
    { const bool h = (lane & 8) != 0;
#pragma unroll
      for (int e = 0; e < 2; ++e) { const float send = h ? a[e] : a[e + 2], keep = h ? a[e + 2] : a[e]; a[e] = keep + __shfl_xor(send, 8); } }
    { const bool h = (lane & 4) != 0; const float send = h ? a[0] : a[1], keep = h ? a[1] : a[0]; a[0] = keep + __shfl_xor(send, 4); }
    float lg = a[0]; lg += __shfl_xor(lg, 1); lg += __shfl_xor(lg, 2);
    float mx = lg;
#pragma unroll
    for (int o = 4; o < 64; o <<= 1) mx = fmaxf(mx, __shfl_xor(mx, o));
    const float val = expf(lg - mx); float sum = val;
#pragma unroll
    for (int o = 4; o < 64; o <<= 1) sum += __shfl_xor(sum, o);
    if ((lane & 3) == 0) AFFT[((size_t)(m >> 11) * 16 + (lane >> 2)) * SEQ + (m & 2047)] = val / sum;
}
template <bool XF32> __device__ __forceinline__ void norm2_router(Frame& F, const Args& A, int L, const void* xsrc) {
    const int lane = opq(F.lane); LAS float* wl = (LAS float*)(F.lds + RING_OFF);
    const float* wr = A.in[I_ROUTER] + (size_t)L * D * NE;
    for (int idx = opq(F.tid); idx < D * NE; idx += NWAVES * 64) wl[(idx & 15) * 1024 + (idx >> 4)] = wr[idx];
    __syncthreads();
    const float* g = A.in[I_GFFN] + (size_t)L * D; f32x4 gg[4];
#pragma unroll
    for (int j = 0; j < 4; ++j) gg[j] = ((const GAS f32x4*)g)[lane + 64 * j];
    unsigned char* HN8 = (unsigned char*)(F.ws + WS_HN8); float* AFFT = (float*)(F.ws + WS_AFFT);
    const int step = 2 * F.NGW;
    XRow<XF32> xc0, xc1, xn0, xn1;
    { const int m1 = (F.gw + F.NGW < M) ? F.gw + F.NGW : F.gw; xc0.load(xsrc, F.gw, lane); xc1.load(xsrc, m1, lane); }
    for (int m = F.gw; m < M; m += step) {
        const int m1 = (m + F.NGW < M) ? m + F.NGW : m;
        { const int n0 = (m + step < M) ? m + step : m, n1 = (n0 + F.NGW < M) ? n0 + F.NGW : n0; xn0.load(xsrc, n0, lane); xn1.load(xsrc, n1, lane); }
        f32x4 v0[4], v1[4]; xc0.get(v0); xc1.get(v1);
        rms_apply(v0, gg); rms_apply(v1, gg);
        { GAS unsigned* o4 = (GAS unsigned*)(HN8 + (size_t)m * D) + lane; GAS unsigned* o5 = (GAS unsigned*)(HN8 + (size_t)m1 * D) + lane;
#pragma unroll
          for (int j = 0; j < 4; ++j) { o4[64 * j] = pg8::pk4_fp8(v0[j].x * 16.f, v0[j].y * 16.f, v0[j].z * 16.f, v0[j].w * 16.f); o5[64 * j] = pg8::pk4_fp8(v1[j].x * 16.f, v1[j].y * 16.f, v1[j].z * 16.f, v1[j].w * 16.f); } }
        typedef float f2r __attribute__((ext_vector_type(2)));
        float a0[16], a1[16];
#pragma unroll
        for (int e = 0; e < 16; ++e) { f2r p0 = {0.f, 0.f}, q0 = {0.f, 0.f}, p1 = {0.f, 0.f}, q1 = {0.f, 0.f};
#pragma unroll
            for (int j = 0; j < 4; ++j) { const f32x4 w4 = *(const LAS f32x4*)(wl + e * 1024 + 256 * j + 4 * lane); const f2r wxy = {w4.x, w4.y}, wzw = {w4.z, w4.w};
                p0 = __builtin_elementwise_fma((f2r){v0[j].x, v0[j].y}, wxy, p0); q0 = __builtin_elementwise_fma((f2r){v0[j].z, v0[j].w}, wzw, q0);
                p1 = __builtin_elementwise_fma((f2r){v1[j].x, v1[j].y}, wxy, p1); q1 = __builtin_elementwise_fma((f2r){v1[j].z, v1[j].w}, wzw, q1); }
            { const f2r t0 = p0 + q0, t1 = p1 + q1; a0[e] = t0.x + t0.y; a1[e] = t1.x + t1.y; }
            if ((e & 3) == 3) asm volatile("" : "+v"(a0[e - 3]), "+v"(a0[e - 2]), "+v"(a0[e - 1]), "+v"(a0[e]), "+v"(a1[e - 3]), "+v"(a1[e - 2]), "+v"(a1[e - 1]), "+v"(a1[e]) :: "memory"); }
        router_finish(a0, lane, m, AFFT); router_finish(a1, lane, m1, AFFT);
        xc0 = xn0; xc1 = xn1;
    }
    __syncthreads();
}
__device__ __forceinline__ void topk_gather_phase(Frame& F) {
    LAS int* cw = (LAS int*)(F.lds + RING_OFF);
    LAS int* sel = (LAS int*)(F.lds + RING_OFF + 1024);
    const float* AFFT = (const float*)(F.ws + WS_AFFT); int* IDX = (int*)(F.ws + WS_IDX); float* GATE = (float*)(F.ws + WS_GATE); int* SLOTOF = (int*)(F.ws + WS_SLOTOF);
    const unsigned char* HN8 = (const unsigned char*)(F.ws + WS_HN8); unsigned char* XIN = (unsigned char*)(F.ws + WS_XIN);
    const int tid = opq(F.tid), lane = tid & 63, wave = F.wave;
    for (int u = blockIdx.x; u < BATCH * NE; u += F.G) {
        const int b = u >> 4, e = u & 15;
        const f32x4 a4 = *(const GAS f32x4*)(AFFT + (size_t)u * SEQ + 4 * tid);
        unsigned k[4];
#pragma unroll
        for (int q = 0; q < 4; ++q) k[q] = __float_as_uint(a4[q]);
        unsigned cand = 0u;
        for (int bit = 30; bit >= 0; --bit) {
            const unsigned tr = cand | (1u << bit);
            int c = 0;
#pragma unroll
            for (int q = 0; q < 4; ++q) c += __builtin_popcountll(__ballot(k[q] >= tr));
            LAS int* cb = cw + (bit & 1) * 8;
            if (lane == 0) cb[wave] = c;
            __syncthreads();
            int tot = 0;
#pragma unroll
            for (int w = 0; w < 8; ++w) tot += cb[w];
            if (tot >= CAP) cand = tr;
        }
        int cg = 0, ce = 0;
#pragma unroll
        for (int q = 0; q < 4; ++q) { cg += (k[q] > cand) ? 1 : 0; ce += (k[q] == cand) ? 1 : 0; }
        int pk = cg | (ce << 16), inc = pk;
#pragma unroll
        for (int o = 1; o < 64; o <<= 1) { const int t = __shfl_up(inc, o); if (lane >= o) inc += t; }
        __syncthreads();
        if (lane == 63) cw[16 + wave] = inc;
        __syncthreads();
        int woff = 0, total = 0;
#pragma unroll
        for (int w = 0; w < 8; ++w) { const int t = cw[16 + w]; if (w < wave) woff += t; total += t; }
        const int count_gt = total & 0xffff;
        int pg = ((woff + inc - pk) & 0xffff), pe = ((woff + inc - pk) >> 16);
        const int slotbase = (e * BATCH + b) * CAP;
#pragma unroll
        for (int q = 0; q < 4; ++q) { const int i = 4 * tid + q, tokrow = b * SEQ + i; int slot = -1;
            if (k[q] > cand) { slot = pg; ++pg; }
            else if (k[q] == cand) { if (count_gt + pe < CAP) slot = count_gt + pe; ++pe; }
            if (slot >= 0) { IDX[slotbase + slot] = tokrow; GATE[slotbase + slot] = a4[q]; sel[slot] = tokrow; }
            SLOTOF[(size_t)tokrow * 16 + e] = slot; }
        __syncthreads();
#pragma unroll
        for (int g8 = 0; g8 < 4; ++g8) { v4u t[8];
#pragma unroll
            for (int j = 0; j < 8; ++j) { const int s = wave + 8 * (8 * g8 + j); t[j] = ((const GAS v4u*)(HN8 + (size_t)sel[s] * D))[lane]; }
#pragma unroll
            for (int j = 0; j < 8; ++j) { const int s = wave + 8 * (8 * g8 + j); ((GAS v4u*)(XIN + (size_t)(slotbase + s) * D))[lane] = t[j]; } }
        __syncthreads();
    }
}
template <bool XF32, bool OF32> __device__ __forceinline__ void combine_norm(Frame& F, const float* gnext, const bool out_fp8, const void* xsrc, void* xdst) {
    const int lane = opq(F.lane); const int* SLOTOF = (const int*)(F.ws + WS_SLOTOF); const unsigned char* Y = (const unsigned char*)(F.ws + WS_Y); bf16* HN = (bf16*)(F.ws + WS_HN);
    f32x4 gg[4];
#pragma unroll
    for (int j = 0; j < 4; ++j) gg[j] = gnext ? ((const GAS f32x4*)gnext)[lane + 64 * j] : (f32x4){0.f, 0.f, 0.f, 0.f};
    int so; XRow<XF32> xc, xn;
    xc.load(xsrc, F.gw, lane); so = SLOTOF[(size_t)F.gw * 16 + (lane & 15)];
    for (int m = F.gw; m < M; m += F.NGW) {
        const int mn = (m + F.NGW < M) ? m + F.NGW : m;
        xn.load(xsrc, mn, lane);
        const int nso = SLOTOF[(size_t)mn * 16 + (lane & 15)];
        f32x4 v[4]; xc.get(v);
        const int b = m >> 11;
        unsigned yv[16][4]; int se[16];
#pragma unroll
        for (int e = 0; e < 16; ++e) { se[e] = __shfl(so, e);
            if (se[e] >= 0) { const GAS unsigned* yr = (const GAS unsigned*)(Y + ((size_t)((e * BATCH + b) * CAP + se[e])) * D) + lane;
#pragma unroll
                for (int j = 0; j < 4; ++j) yv[e][j] = yr[64 * j]; } }
#pragma unroll
        for (int e = 0; e < 16; ++e) {
            if (se[e] >= 0) {
#pragma unroll
                for (int j = 0; j < 4; ++j) { typedef float f2_ __attribute__((ext_vector_type(2))); const f2_ lo = __builtin_amdgcn_cvt_pk_f32_fp8((int)yv[e][j], false), hi = __builtin_amdgcn_cvt_pk_f32_fp8((int)yv[e][j], true);
                    v[j].x += lo.x * (1.0f / 64.0f); v[j].y += lo.y * (1.0f / 64.0f); v[j].z += hi.x * (1.0f / 64.0f); v[j].w += hi.y * (1.0f / 64.0f); } } }
        if (OF32) { GAS f32x4* xw = (GAS f32x4*)((float*)xdst + (size_t)m * D) + lane;
#pragma unroll
          for (int j = 0; j < 4; ++j) xw[64 * j] = v[j]; }
        else store_row_bf16((bf16*)xdst + (size_t)m * D, lane, v);
        if (gnext) { rms_apply(v, gg);
            if (out_fp8) { GAS unsigned* o4 = (GAS unsigned*)((unsigned char*)HN + (size_t)m * D) + lane;
#pragma unroll
                for (int j = 0; j < 4; ++j) o4[64 * j] = pg8::pk4_fp8(v[j].x * 16.f, v[j].y * 16.f, v[j].z * 16.f, v[j].w * 16.f); }
            else store_row_bf16(HN + (size_t)m * D, lane, v); }
        xc = xn; so = nso;
    }
}

#ifndef PROBE_DUP
#define PROBE_DUP 0
#endif
#ifndef PROBE_L
#define PROBE_L 15
#endif
#define REP(bit) _Pragma("unroll") for (int rep_ = 0; rep_ < (((PROBE_DUP >> (bit)) & 1) & ((PROBE_L >> L) & 1)) + 1; ++rep_)
constexpr int PPL = 11;
constexpr int NPHASE = 1 + NLAYER * PPL;
template <int L> __device__ __forceinline__ void layer_body(const Args& args, const int lo, const int hi, unsigned char* lds_raw, const int wave_s) {
#define IN(k) (lo <= (k) && (k) < hi)
#define SEAM(k) do { if (IN(k) && IN((k) + 1)) { const XcdBarrier bar_ = make_bar(args, lds_raw); const Frame Fb_ = make_frame(args, lds_raw, wave_s); xcd_barrier(bar_, Fb_.tid == 0); } } while (0)
    unsigned char* ws = args.ws;
    bf16* HN = (bf16*)(ws + WS_HN); bf16* QKV = (bf16*)(ws + WS_QKV); bf16* OB = (bf16*)(ws + WS_O);

        const int pb = 1 + L * PPL;
        const int nqkv = (L == 3) ? 9216 : 3072;
        REP(4) {
        if (IN(pb + 0)) { Frame F = make_frame(args, lds_raw, wave_s);
            constexpr bool Q8 = (L == 3);
            pg8::Gemm g{HN, (const bf16*)(ws + wqkv_off(L)), M, nqkv, Q8 ? D / 2 : D}; pg8::StaticOrder S; S.init(M, nqkv, F.G, (int)blockIdx.x);
            const float* qg = (L == 0) ? args.in[I_NA_QN] : (L == 1) ? args.in[I_DF_QN] : args.in[I_DL_QN]; const float* kg = (L == 0) ? args.in[I_NA_KN] : (L == 1) ? args.in[I_DF_KN] : args.in[I_DL_KN];
            pg8::EpiQKV E{QKV, nqkv, qg, kg, (L == 1 || L == 3) ? (const float*)(ws + WS_ROPE) : nullptr, attn_body::C2  , (L == 2) ? 1 : 0, EPS, Q8 ? 1.0f / 4096.0f : 1.0f, (L == 0) ? 1 : (L == 1) ? 2 : (L == 2) ? 0 : 3};
            pg8::gemm_phase<pg8::EpiQKV, pg8::StaticOrder, true, true, Q8>(F.lds + RING_OFF, g, S, E, F.tid);
        } SEAM(pb + 0);
        }
        REP(3) {
        if (IN(pb + 2)) { Frame F = make_frame(args, lds_raw, wave_s);
            if constexpr (L == 0) na_attn_phase(F, QKV, args.in[I_NA_RPB], OB, args.in[I_NA_QN], args.in[I_NA_KN]);
            else if constexpr (L == 1) diff_attn_phase2(F, args, QKV, OB, 0.8f - 0.6f * 0.7408182206817179f, (char*)lds_raw);
            else if constexpr (L == 2) conv_naive(F, QKV, args.in[I_SC_CONV], OB);
            else dil_attn_coop(F, QKV, (bf16*)(ws + WS_OG), (float*)(ws + WS_LSE), args.in[I_DL_QN], args.in[I_DL_KN]);
        } SEAM(pb + 2);
        }
        REP(6) {
        if (IN(pb + 3)) { Frame F = make_frame(args, lds_raw, wave_s);
            if constexpr (L == 3) dil_merge(F, (const unsigned char*)(ws + WS_OG), (const float*)(ws + WS_LSE), (unsigned char*)OB);
        } if constexpr (L == 3) SEAM(pb + 3);
        }
        REP(5) {
        if (IN(pb + 4)) { Frame F = make_frame(args, lds_raw, wave_s);
            constexpr bool O8 = (L == 3);
            pg8::Gemm g{OB, (const bf16*)(ws + WS_WOUT + (size_t)L * 2 * MiB), M, D, O8 ? D / 2 : D}; pg8::StaticOrder S; S.init(M, D, F.G, (int)blockIdx.x);
            if constexpr (L == 0) { pg8::EpiResidB<true> E{args.in[I_X], (bf16*)(ws + WS_XB), D, 1.0f}; pg8::gemm_phase<pg8::EpiResidB<true>, pg8::StaticOrder, true, true, false>(F.lds + RING_OFF, g, S, E, F.tid); }
            else { pg8::EpiResidB<false> E{ws + WS_XB, (bf16*)(ws + WS_XB), D, O8 ? 1.0f / 4096.0f : 1.0f}; pg8::gemm_phase<pg8::EpiResidB<false>, pg8::StaticOrder, true, true, O8>(F.lds + RING_OFF, g, S, E, F.tid); }
        } SEAM(pb + 4);
        }
        REP(1) {
        if (IN(pb + 5)) { Frame F = make_frame(args, lds_raw, wave_s); norm2_router<false>(F, args, L, ws + WS_XB); } SEAM(pb + 5);
        }
        REP(1) {
        if (IN(pb + 6)) { Frame F = make_frame(args, lds_raw, wave_s); topk_gather_phase(F); } SEAM(pb + 6);
        }
        REP(1) {
        }
        REP(2) {
        if (IN(pb + 8)) { Frame F = make_frame(args, lds_raw, wave_s);
            pg8::Gemm g{(const bf16*)(ws + WS_XIN), (const bf16*)(ws + WS_WGU + (size_t)L * 64 * MiB), NSLOT, 2 * DFF, D / 2}; pg8::MoeOrder S; S.init(NE, 16, 16, F.G, F.vcu, 3);
            pg8::EpiSwiglu8 E{(unsigned char*)(ws + WS_HMID), DFF, 16, 1.0f / (16.0f * 256.0f), 8.0f};
            pg8::gemm_phase<pg8::EpiSwiglu8, pg8::MoeOrder, true, true, true>(F.lds + RING_OFF, g, S, E, F.tid);
        } SEAM(pb + 8);
        }
        REP(7) {
        if (IN(pb + 9)) { Frame F = make_frame(args, lds_raw, wave_s);
            pg8::Gemm g{(const bf16*)(ws + WS_HMID), (const bf16*)(ws + WS_WDN + (size_t)L * 32 * MiB), NSLOT, D, DFF / 2}; pg8::MoeOrder S; S.init(NE, 16, 4, F.G, F.vcu);
            pg8::EpiGate E{(unsigned char*)(ws + WS_Y), D, 4, (const float*)(ws + WS_GATE), 64.0f / (8.0f * 256.0f)};
            pg8::gemm_phase<pg8::EpiGate, pg8::MoeOrder, true, true, true>(F.lds + RING_OFF, g, S, E, F.tid);
        } SEAM(pb + 9);
        }
        if (IN(pb + 10)) { Frame F = make_frame(args, lds_raw, wave_s); const float* gnext = L + 1 < NLAYER ? args.in[I_GMIX] + (size_t)(L + 1) * D : nullptr;
            if constexpr (L + 1 < NLAYER) combine_norm<false, false>(F, gnext, (L + 1) == 3, ws + WS_XB, ws + WS_XB);
            else combine_norm<false, true>(F, gnext, false, ws + WS_XB, F.out); } SEAM(pb + 10);
    #undef IN
#undef SEAM
}
__global__ void __launch_bounds__(NWAVES * 64, 2) fwd_kernel(Args args) {
    extern __shared__ __attribute__((aligned(16))) unsigned char lds[];
    { const int tid0 = threadIdx.x; for (int u = tid0; u < (LDS_BYTES - LDSCTL_OFF) / 4; u += NWAVES * 64) ((LAS unsigned*)((LAS unsigned char*)lds + LDSCTL_OFF))[u] = 0u; }
    __syncthreads();
    const int wave_s = __builtin_amdgcn_readfirstlane((int)threadIdx.x >> 6);
    const int lo = args.ph_lo, hi = args.ph_hi;
    if (hi - lo > 1) (void)xcd_barrier_post((unsigned*)((gu32*)(args.ws + WS_CTL) + CW_BAR) + args.li * XCD_BAR_WORDS, (volatile LAS unsigned*)((LAS unsigned char*)lds + MISC_OFF) + 8);
#define IN(k) (lo <= (k) && (k) < hi)
#define SEAM(k) do { if (IN(k) && IN((k) + 1)) { const XcdBarrier bar_ = make_bar(args, lds); const Frame Fb_ = make_frame(args, lds, wave_s); xcd_barrier(bar_, Fb_.tid == 0); } } while (0)
    { constexpr int L = 0; REP(0) { if (IN(0)) { Frame F = make_frame(args, lds, wave_s); p0_prologue(F, args); } SEAM(0); } }
#ifdef PROBE_BARS
    for (int xb_ = 0; xb_ < PROBE_BARS; ++xb_) { const XcdBarrier bar_ = make_bar(args, lds); const Frame Fb_ = make_frame(args, lds, wave_s); xcd_barrier(bar_, Fb_.tid == 0); }
#endif

    layer_body<0>(args, lo, hi, lds, wave_s); layer_body<1>(args, lo, hi, lds, wave_s); layer_body<2>(args, lo, hi, lds, wave_s); layer_body<3>(args, lo, hi, lds, wave_s);
#undef IN
#undef SEAM
}

#ifndef MK_N_LAUNCHES
#define MK_N_LAUNCHES 1
#endif
extern "C" void kernel_launch(void* const* d_in, const int* in_sizes, int n_in, void* d_out, int out_size, void* d_ws, size_t ws_size, hipStream_t stream) {
    static int grid = 0;
    if (grid == 0) {
        if (n_in != N_IN || in_sizes[0] != M * D || out_size != M * D || ws_size < WS_END) { fprintf(stderr, "kernel_launch: unexpected shapes: n_in %d in0 %d out %d ws %zu (need %zu)\n", n_in, n_in > 0 ? in_sizes[0] : -1, out_size, ws_size, (size_t)WS_END); grid = -1; return; }
        int dev = 0, cus = 0, per_cu = 0;
        if (hipGetDevice(&dev) != hipSuccess || hipDeviceGetAttribute(&cus, hipDeviceAttributeMultiprocessorCount, dev) != hipSuccess) { grid = -1; return; }
        if (hipFuncSetAttribute((const void*)fwd_kernel, hipFuncAttributeMaxDynamicSharedMemorySize, LDS_BYTES) != hipSuccess) { fprintf(stderr, "kernel_launch: hipFuncSetAttribute failed\n"); grid = -1; return; }
        if (hipOccupancyMaxActiveBlocksPerMultiprocessor(&per_cu, (const void*)fwd_kernel, NWAVES * 64, LDS_BYTES) != hipSuccess || per_cu < 1) fprintf(stderr, "kernel_launch: occupancy query reports %d\n", per_cu);
        (void)hipGetLastError();
        grid = cus;
    }
    if (grid < 0) return;
    if (hipMemsetAsync((char*)d_ws + WS_CTL, 0, CTL_ZERO_BYTES, stream) != hipSuccess) return;
    Args a{};
    for (int i = 0; i < N_IN; ++i) a.in[i] = (const float*)d_in[i];
    a.out = (float*)d_out; a.ws = (unsigned char*)d_ws; a.pad = 0;
    if (MK_N_LAUNCHES == 1) {
        a.ph_lo = 0; a.ph_hi = NPHASE; a.li = 0;
        hipLaunchKernelGGL(fwd_kernel, dim3(grid), dim3(NWAVES * 64), LDS_BYTES, stream, a);
    } else {
        for (int p = 0; p < NPHASE; ++p) { a.ph_lo = p; a.ph_hi = p + 1; a.li = 0;
            hipLaunchKernelGGL(fwd_kernel, dim3(grid), dim3(NWAVES * 64), LDS_BYTES, stream, a); }
    }
    const hipError_t le = hipPeekAtLastError();
    if (le != hipSuccess) fprintf(stderr, "kernel_launch: launch failed: %s\n", hipGetErrorName(le));
}
```
